# Optimizing an MI355X kernel written in HIP

```python
import math
import jax
import jax.numpy as jnp
from jax import lax
import numpy as np

D_MODEL = 1024
BATCH = 4
SEQ = 4096
DEPTH = 4
DEC_BATCH = 128
DEC_SEQ = 4
PAST_LEN = 8192
PAGE_SIZE = 128

HEAD_DIM = 64
N_Q_HEADS = 8
N_KV_HEADS = 2
Q_PER_KV = N_Q_HEADS // N_KV_HEADS
ATTN_WIDTH = N_Q_HEADS * HEAD_DIM
KV_WIDTH = N_KV_HEADS * HEAD_DIM
WINDOW = 128
ROPE_THETA = 10000.0
ATTN_SCALE = 1.0 / math.sqrt(HEAD_DIM)
SSM_WIDTH = D_MODEL // 4
SSM_GROUP = 16
N_SSM_GROUPS = SSM_WIDTH // SSM_GROUP
SSM_STATE = 64
CONV_WIDTH = D_MODEL // 4
CONV_K = 31
MIX_WIDTH = ATTN_WIDTH + SSM_WIDTH + CONV_WIDTH
IN_WIDTH = ATTN_WIDTH + 2 * KV_WIDTH + SSM_WIDTH + 2 * CONV_WIDTH
D_FF = -(-8 * D_MODEL // (3 * 256)) * 256
EPS = 1e-6
NEG = -1e30

kernel_name = 'hybrid_s5_conformer_swa_decoder_step'


def _rmsnorm(x, g):
    xf = x.astype(jnp.float32)
    y = xf * lax.rsqrt(jnp.mean(xf * xf, axis=-1, keepdims=True) + EPS)
    return (y * g.astype(jnp.float32)).astype(x.dtype)


def _layernorm(x, g, b):
    xf = x.astype(jnp.float32)
    xc = xf - jnp.mean(xf, axis=-1, keepdims=True)
    var = jnp.mean(xc * xc, axis=-1, keepdims=True)
    y = xc * lax.rsqrt(var + EPS) * g.astype(jnp.float32) + b.astype(jnp.float32)
    return y.astype(x.dtype)


def _rope(x, pos):
    half = HEAD_DIM // 2
    inv_freq = ROPE_THETA ** (-jnp.arange(half, dtype=jnp.float32) / half)
    ang = pos.astype(jnp.float32)[:, None] * inv_freq[None, :]
    cos = jnp.cos(ang)[None, :, None, :]
    sin = jnp.sin(ang)[None, :, None, :]
    xf = x.astype(jnp.float32)
    x1, x2 = xf[..., :half], xf[..., half:]
    return jnp.concatenate([x1 * cos - x2 * sin, x2 * cos + x1 * sin], axis=-1).astype(x.dtype)


def _sink_softmax(s, sinks):
    sk = sinks.astype(jnp.float32).reshape(N_KV_HEADS, Q_PER_KV, 1, 1)
    m = jnp.maximum(jnp.max(s, axis=-1, keepdims=True), sk)
    e = jnp.exp(s - m)
    return e / (jnp.sum(e, axis=-1, keepdims=True) + jnp.exp(sk - m))


def _attn_banded(q, k, v, sinks):
    b, l = q.shape[0], q.shape[1]
    nb = l // WINDOW
    qb = q.reshape(b, nb, WINDOW, N_KV_HEADS, Q_PER_KV, HEAD_DIM)
    kb = k.reshape(b, nb, WINDOW, N_KV_HEADS, HEAD_DIM)
    vb = v.reshape(b, nb, WINDOW, N_KV_HEADS, HEAD_DIM)
    pad = ((0, 0), (1, 0), (0, 0), (0, 0), (0, 0))
    kk = jnp.concatenate([jnp.pad(kb, pad)[:, :-1], kb], axis=2)
    vv = jnp.concatenate([jnp.pad(vb, pad)[:, :-1], vb], axis=2)
    s = jnp.einsum('bnqhgd,bnkhd->bnhgqk', qb, kk, preferred_element_type=jnp.float32) * ATTN_SCALE
    blk = jnp.arange(nb)[:, None, None]
    qi = jnp.arange(WINDOW)[None, :, None]
    kj = jnp.arange(2 * WINDOW)[None, None, :]
    rel = WINDOW + qi - kj
    mask = (rel >= 0) & (rel < WINDOW) & (blk * WINDOW - WINDOW + kj >= 0)
    s = jnp.where(mask[None, :, None, None], s, NEG)
    p = _sink_softmax(s, sinks)
    o = jnp.einsum('bnhgqk,bnkhd->bnqhgd', p.astype(v.dtype), vv)
    return o.reshape(b, l, ATTN_WIDTH)


def _attn_window_cache(q, k, v, k_buf, v_buf, sinks, pos0):
    b, t = q.shape[0], q.shape[1]
    wb = k_buf.shape[1]
    kk = jnp.concatenate([k_buf.astype(k.dtype), k], axis=1)
    vv = jnp.concatenate([v_buf.astype(v.dtype), v], axis=1)
    qg = q.reshape(b, t, N_KV_HEADS, Q_PER_KV, HEAD_DIM)
    s = jnp.einsum('bqhgd,bkhd->bhgqk', qg, kk, preferred_element_type=jnp.float32) * ATTN_SCALE
    qpos = pos0 + jnp.arange(t)
    kpos = pos0 - wb + jnp.arange(wb + t)
    rel = qpos[:, None] - kpos[None, :]
    mask = (rel >= 0) & (rel < WINDOW)
    s = jnp.where(mask, s, NEG)
    p = _sink_softmax(s, sinks)
    o = jnp.einsum('bhgqk,bkhd->bqhgd', p.astype(v.dtype), vv).reshape(b, t, ATTN_WIDTH)
    return o, kk[:, t:], vv[:, t:]


def _complex_affine_combine(e1, e2):
    a1r, a1i, b1r, b1i = e1
    a2r, a2i, b2r, b2i = e2
    ar = a2r * a1r - a2i * a1i
    ai = a2r * a1i + a2i * a1r
    br = a2r * b1r - a2i * b1i + b2r
    bi = a2r * b1i + a2i * b1r + b2i
    return ar, ai, br, bi


def _s5(zu, h0_re, h0_im, lam_re, lam_im, log_dt, b_re, b_im, c_re, c_im, d_skip, w_glu, b_glu):
    f32 = jnp.float32
    bsz, l = zu.shape[0], zu.shape[1]
    u = zu.astype(f32).reshape(bsz, l, N_SSM_GROUPS, SSM_GROUP)
    lr, li = lam_re.astype(f32), lam_im.astype(f32)
    dt = jnp.exp(log_dt.astype(f32))[:, None]
    mag = jnp.exp(lr * dt)
    ab_re = mag * jnp.cos(li * dt)
    ab_im = mag * jnp.sin(li * dt)
    den = lr * lr + li * li
    nr = ab_re - 1.0
    coef_re = (nr * lr + ab_im * li) / den
    coef_im = (ab_im * lr - nr * li) / den
    br, bi = b_re.astype(f32), b_im.astype(f32)
    bb_re = coef_re[..., None] * br - coef_im[..., None] * bi
    bb_im = coef_re[..., None] * bi + coef_im[..., None] * br
    bu_re = jnp.einsum('gpc,blgc->blgp', bb_re, u)
    bu_im = jnp.einsum('gpc,blgc->blgp', bb_im, u)
    a_re = jnp.broadcast_to(ab_re, bu_re.shape)
    a_im = jnp.broadcast_to(ab_im, bu_im.shape)
    acc_r, acc_i, sb_r, sb_i = lax.associative_scan(_complex_affine_combine, (a_re, a_im, bu_re, bu_im), axis=1)
    hr0 = h0_re.astype(f32)[:, None]
    hi0 = h0_im.astype(f32)[:, None]
    h_re = acc_r * hr0 - acc_i * hi0 + sb_r
    h_im = acc_r * hi0 + acc_i * hr0 + sb_i
    y = jnp.einsum('gcp,blgp->blgc', c_re.astype(f32), h_re) - jnp.einsum('gcp,blgp->blgc', c_im.astype(f32), h_im)
    y = (y + d_skip.astype(f32).reshape(N_SSM_GROUPS, SSM_GROUP) * u).reshape(bsz, l, SSM_WIDTH)
    z = jax.nn.gelu(y)
    out = z * jax.nn.sigmoid(z @ w_glu.astype(f32) + b_glu.astype(f32))
    return out.astype(zu.dtype), h_re[:, -1], h_im[:, -1]


def _conv_module(za, zg, buf, conv_w, conv_b, ln_g, ln_b):
    v = za * jax.nn.sigmoid(zg)
    full = jnp.concatenate([buf.astype(v.dtype), v], axis=1)
    y = lax.conv_general_dilated(full, conv_w.astype(v.dtype)[:, None, :], window_strides=(1,), padding='VALID',
                                 dimension_numbers=('NWC', 'WIO', 'NWC'), feature_group_count=CONV_WIDTH)
    y = y + conv_b.astype(v.dtype)
    y = jax.nn.silu(_layernorm(y, ln_g, ln_b))
    return y, full[:, full.shape[1] - (CONV_K - 1):]


def _layer(x, c, pos0, k_buf, v_buf, h0_re, h0_im, conv_buf, w, prompt):
    b, l = x.shape[0], x.shape[1]
    mod = jax.nn.silu(c) @ w['w_mod'] + w['b_mod']
    sh1, sc1, g1, sh2, sc2, g2 = jnp.split(mod[:, None, :], 6, axis=-1)
    h = _rmsnorm(x, w['norm1_g']) * (1 + sc1) + sh1
    z = h @ w['w_in']
    o1 = ATTN_WIDTH
    o2 = o1 + KV_WIDTH
    o3 = o2 + KV_WIDTH
    o4 = o3 + SSM_WIDTH
    o5 = o4 + CONV_WIDTH
    zq, zk, zv, zu, za, zg = jnp.split(z, [o1, o2, o3, o4, o5], axis=-1)
    pos = pos0 + jnp.arange(l)
    q = _rope(zq.reshape(b, l, N_Q_HEADS, HEAD_DIM), pos)
    k = _rope(zk.reshape(b, l, N_KV_HEADS, HEAD_DIM), pos)
    v = zv.reshape(b, l, N_KV_HEADS, HEAD_DIM)
    if prompt:
        o_attn = _attn_banded(q, k, v, w['sinks'])
        n_keep = min(WINDOW, l)
        new_k, new_v = k[:, l - n_keep:], v[:, l - n_keep:]
    else:
        o_attn, new_k, new_v = _attn_window_cache(q, k, v, k_buf, v_buf, w['sinks'], pos0)
    o_ssm, h_re, h_im = _s5(zu, h0_re, h0_im, w['lam_re'], w['lam_im'], w['log_dt'], w['b_re'], w['b_im'],
                            w['c_re'], w['c_im'], w['d_skip'], w['w_glu'], w['b_glu'])
    o_conv, new_conv = _conv_module(za, zg, conv_buf, w['conv_w'], w['conv_b'], w['conv_ln_g'], w['conv_ln_b'])
    mixed = jnp.concatenate([o_attn.astype(x.dtype), o_ssm.astype(x.dtype), o_conv.astype(x.dtype)], axis=-1)
    x = x + g1 * (mixed @ w['w_out'])
    h2 = _rmsnorm(x, w['norm2_g']) * (1 + sc2) + sh2
    ffn = (jax.nn.silu(h2 @ w['w_gate']) * (h2 @ w['w_up'])) @ w['w_down']
    x = x + g2 * ffn
    return x, new_k, new_v, h_re, h_im, new_conv


def setup_inputs(seed: int = 0) -> dict:
    key = jax.random.key(seed)
    ks = jax.random.split(key, 40)
    f32 = jnp.float32

    def nrm(k, shape, s):
        return jax.random.normal(k, shape, f32) * s

    wb = min(WINDOW, PAST_LEN)
    lam_im = jnp.pi * jnp.arange(SSM_STATE, dtype=f32)[None, None, :] + nrm(ks[15], (DEPTH, N_SSM_GROUPS, SSM_STATE), 0.01)
    return {
        'x_prompt': nrm(ks[0], (BATCH, SEQ, D_MODEL), 1.0),
        'x_sample': nrm(ks[1], (DEC_BATCH, DEC_SEQ, D_MODEL), 1.0),
        'c_prompt': nrm(ks[2], (BATCH, D_MODEL), 1.0),
        'c_sample': nrm(ks[3], (DEC_BATCH, D_MODEL), 1.0),
        'cache_k': nrm(ks[4], (DEPTH, DEC_BATCH, wb, N_KV_HEADS, HEAD_DIM), 1.0),
        'cache_v': nrm(ks[5], (DEPTH, DEC_BATCH, wb, N_KV_HEADS, HEAD_DIM), 1.0),
        'state_ssm_re': nrm(ks[6], (DEPTH, DEC_BATCH, N_SSM_GROUPS, SSM_STATE), 0.5),
        'state_ssm_im': nrm(ks[7], (DEPTH, DEC_BATCH, N_SSM_GROUPS, SSM_STATE), 0.5),
        'state_conv': nrm(ks[8], (DEPTH, DEC_BATCH, CONV_K - 1, CONV_WIDTH), 0.5),
        'norm1_g': 1.0 + nrm(ks[9], (DEPTH, D_MODEL), 0.05),
        'norm2_g': 1.0 + nrm(ks[10], (DEPTH, D_MODEL), 0.05),
        'w_mod': nrm(ks[11], (DEPTH, D_MODEL, 6 * D_MODEL), 0.5 * D_MODEL ** -0.5),
        'b_mod': nrm(ks[12], (DEPTH, 6 * D_MODEL), 0.01),
        'w_in': nrm(ks[13], (DEPTH, D_MODEL, IN_WIDTH), D_MODEL ** -0.5),
        'attn_sinks': nrm(ks[14], (DEPTH, N_Q_HEADS), 0.5),
        'ssm_lam_re': -0.5 + nrm(ks[16], (DEPTH, N_SSM_GROUPS, SSM_STATE), 0.01),
        'ssm_lam_im': lam_im,
        'ssm_log_dt': jax.random.uniform(ks[17], (DEPTH, N_SSM_GROUPS), f32, minval=math.log(1e-3), maxval=math.log(1e-1)),
        'ssm_b_re': nrm(ks[18], (DEPTH, N_SSM_GROUPS, SSM_STATE, SSM_GROUP), (2 * SSM_GROUP) ** -0.5),
        'ssm_b_im': nrm(ks[19], (DEPTH, N_SSM_GROUPS, SSM_STATE, SSM_GROUP), (2 * SSM_GROUP) ** -0.5),
        'ssm_c_re': nrm(ks[20], (DEPTH, N_SSM_GROUPS, SSM_GROUP, SSM_STATE), (2 * SSM_STATE) ** -0.5),
        'ssm_c_im': nrm(ks[21], (DEPTH, N_SSM_GROUPS, SSM_GROUP, SSM_STATE), (2 * SSM_STATE) ** -0.5),
        'ssm_d': nrm(ks[22], (DEPTH, SSM_WIDTH), 1.0),
        'ssm_w_glu': nrm(ks[23], (DEPTH, SSM_WIDTH, SSM_WIDTH), SSM_WIDTH ** -0.5),
        'ssm_b_glu': nrm(ks[24], (DEPTH, SSM_WIDTH), 0.01),
        'conv_w': nrm(ks[25], (DEPTH, CONV_K, CONV_WIDTH), CONV_K ** -0.5),
        'conv_b': nrm(ks[26], (DEPTH, CONV_WIDTH), 0.01),
        'conv_ln_g': 1.0 + nrm(ks[27], (DEPTH, CONV_WIDTH), 0.05),
        'conv_ln_b': nrm(ks[28], (DEPTH, CONV_WIDTH), 0.01),
        'w_out': nrm(ks[29], (DEPTH, MIX_WIDTH, D_MODEL), MIX_WIDTH ** -0.5),
        'w_gate': nrm(ks[30], (DEPTH, D_MODEL, D_FF), D_MODEL ** -0.5),
        'w_up': nrm(ks[31], (DEPTH, D_MODEL, D_FF), D_MODEL ** -0.5),
        'w_down': nrm(ks[32], (DEPTH, D_FF, D_MODEL), D_FF ** -0.5),
        'final_norm_g': 1.0 + nrm(ks[33], (D_MODEL,), 0.05),
    }


def reference(x_prompt, x_sample, c_prompt, c_sample, cache_k, cache_v, state_ssm_re, state_ssm_im, state_conv,
              norm1_g, norm2_g, w_mod, b_mod, w_in, attn_sinks, ssm_lam_re, ssm_lam_im, ssm_log_dt,
              ssm_b_re, ssm_b_im, ssm_c_re, ssm_c_im, ssm_d, ssm_w_glu, ssm_b_glu,
              conv_w, conv_b, conv_ln_g, conv_ln_b, w_out, w_gate, w_up, w_down, final_norm_g):
    xp, xs = x_prompt, x_sample
    bp = xp.shape[0]
    zero_h = jnp.zeros((bp, N_SSM_GROUPS, SSM_STATE), jnp.float32)
    zero_conv = jnp.zeros((bp, CONV_K - 1, CONV_WIDTH), xp.dtype)
    pk, pv, pre, pim, pcv = [], [], [], [], []
    sk, sv, sre, sim, scv = [], [], [], [], []
    for l in range(DEPTH):
        w = {
            'norm1_g': norm1_g[l], 'norm2_g': norm2_g[l], 'w_mod': w_mod[l], 'b_mod': b_mod[l],
            'w_in': w_in[l], 'sinks': attn_sinks[l],
            'lam_re': ssm_lam_re[l], 'lam_im': ssm_lam_im[l], 'log_dt': ssm_log_dt[l],
            'b_re': ssm_b_re[l], 'b_im': ssm_b_im[l], 'c_re': ssm_c_re[l], 'c_im': ssm_c_im[l],
            'd_skip': ssm_d[l], 'w_glu': ssm_w_glu[l], 'b_glu': ssm_b_glu[l],
            'conv_w': conv_w[l], 'conv_b': conv_b[l], 'conv_ln_g': conv_ln_g[l], 'conv_ln_b': conv_ln_b[l],
            'w_out': w_out[l], 'w_gate': w_gate[l], 'w_up': w_up[l], 'w_down': w_down[l],
        }
        xp, k1, v1, r1, i1, cv1 = _layer(xp, c_prompt, 0, None, None, zero_h, zero_h, zero_conv, w, True)
        xs, k2, v2, r2, i2, cv2 = _layer(xs, c_sample, PAST_LEN, cache_k[l], cache_v[l], state_ssm_re[l],
                                         state_ssm_im[l], state_conv[l], w, False)
        pk.append(k1); pv.append(v1); pre.append(r1); pim.append(i1); pcv.append(cv1)
        sk.append(k2); sv.append(v2); sre.append(r2); sim.append(i2); scv.append(cv2)
    y_prompt = _rmsnorm(xp, final_norm_g)
    y_sample = _rmsnorm(xs, final_norm_g)
    return (y_prompt, y_sample,
            jnp.stack(pk), jnp.stack(pv), jnp.stack(pre), jnp.stack(pim), jnp.stack(pcv),
            jnp.stack(sk), jnp.stack(sv), jnp.stack(sre), jnp.stack(sim), jnp.stack(scv))
```

```cpp
#include <hip/hip_runtime.h>
#include <hip/hip_cooperative_groups.h>
#include <cstdio>
#include <cstdint>
namespace cg = cooperative_groups;


#ifndef MK_LAUNCH_PER_PHASE
#define MK_LAUNCH_PER_PHASE 0
#endif

#define LAS __attribute__((address_space(3)))
typedef unsigned short bf16_t;
typedef short bf16x8 __attribute__((ext_vector_type(8)));
typedef float f32x4 __attribute__((ext_vector_type(4)));
typedef float f32x16 __attribute__((ext_vector_type(16)));
typedef unsigned u32x4 __attribute__((ext_vector_type(4)));
typedef unsigned u32x2 __attribute__((ext_vector_type(2)));

constexpr int D = 1024, NPB = 4, SEQ = 4096, DEPTH = 4, NSB = 128, SSEQ = 4;
constexpr int MP = NPB * SEQ;
constexpr int MS = NSB * SSEQ;
constexpr int M = MP + MS;
constexpr int NIN = 1536, DFF = 2816, NGU = 2 * DFF;
constexpr int NMODROWS = NPB + NSB;
constexpr int CT = 16;
constexpr int NCHUNK = MP / CT;
constexpr int KY = 384;
constexpr float EPS = 1e-6f;

constexpr size_t MiB = 1u << 20;
constexpr size_t WS_ROPE = 1 * MiB, WS_SC = 3 * MiB, WS_APOW = 4 * MiB, WS_BB = 5 * MiB, WS_MOD = 8 * MiB;
constexpr size_t WS_WGLU = 22 * MiB, WS_BTE = 23 * MiB, WS_BTY = 28 * MiB, WS_WIN = 40 * MiB, WS_WOUT = 52 * MiB;
constexpr size_t WS_WGU = 60 * MiB, WS_WDN = 104 * MiB, WS_X = 126 * MiB, WS_XN = 192 * MiB, WS_H = 225 * MiB;
constexpr size_t WS_MIX = 225 * MiB, WS_Q = 258 * MiB, WS_K = 275 * MiB, WS_V = 280 * MiB, WS_ZUT = 285 * MiB;
constexpr size_t WS_VC = 297 * MiB, WS_Z = 306 * MiB, WS_ZUS = 315 * MiB, WS_WMOD = 225 * MiB, WS_PART = 316 * MiB, WS_END = 362 * MiB;

constexpr size_t O_YP = 0, O_YS = O_YP + (size_t)MP * D, O_KP = O_YS + (size_t)MS * D, O_VP = O_KP + 262144, O_RP = O_VP + 262144;
constexpr size_t O_IP = O_RP + 16384, O_CP = O_IP + 16384, O_KS = O_CP + 122880, O_VS = O_KS + 8388608, O_RS = O_VS + 8388608;
constexpr size_t O_IS = O_RS + 524288, O_CS = O_IS + 524288, O_END = O_CS + 3932160;

constexpr int LDS_BYTES = 147456;

typedef float f32x2_t __attribute__((ext_vector_type(2))); typedef __bf16 bf16x2_t __attribute__((ext_vector_type(2)));
__device__ __forceinline__ unsigned cvt_pk_bf16(float lo, float hi) { const f32x2_t v = {lo, hi}; const bf16x2_t b = __builtin_convertvector(v, bf16x2_t); return __builtin_bit_cast(unsigned, b); }
__device__ __forceinline__ float bf2f(unsigned h) { return __builtin_bit_cast(float, h << 16); }
__device__ __forceinline__ float bflo(unsigned w) { return __builtin_bit_cast(float, w << 16); }
__device__ __forceinline__ float bfhi(unsigned w) { return __builtin_bit_cast(float, w & 0xffff0000u); }
__device__ __forceinline__ bf16_t f2bf(float f) { return (bf16_t)(cvt_pk_bf16(f, 0.f) & 0xffffu); }
__device__ __forceinline__ float sigmoidf_(float x) { return __builtin_amdgcn_rcpf(1.0f + __expf(-x)); }
__device__ __forceinline__ float gelu_tanh(float y) { const float u = 0.7978845608028654f * (y + 0.044715f * y * y * y); return y * (1.0f - __builtin_amdgcn_rcpf(1.0f + __expf(2.0f * u))); }
__device__ __forceinline__ void cis_rev(double ang, float& c, float& s) { double rev = ang * 0.15915494309189535; rev -= rint(rev); const float x = (float)(rev * 6.283185307179586); s = sinf(x); c = cosf(x); }
__device__ __forceinline__ float swz_f(float v, int pat) { return 0.f; }
#define SWZ(v, pat) __builtin_bit_cast(float, __builtin_amdgcn_ds_swizzle(__builtin_bit_cast(int, (v)), (pat)))
__device__ __forceinline__ float xor32_sum(float v) { float a = v, b = v; asm volatile("s_nop 1\n\tv_permlane32_swap_b32 %0, %1\n\ts_nop 1" : "+v"(a), "+v"(b)); return a + b; }
__device__ __forceinline__ float xor32_max(float v) { float a = v, b = v; asm volatile("s_nop 1\n\tv_permlane32_swap_b32 %0, %1\n\ts_nop 1" : "+v"(a), "+v"(b)); return fmaxf(a, b); }
__device__ __forceinline__ float wave_sum(float v) {
    v += SWZ(v, 0x041f); v += SWZ(v, 0x081f); v += SWZ(v, 0x101f); v += SWZ(v, 0x201f); v += SWZ(v, 0x401f); return xor32_sum(v);
}
__device__ __forceinline__ float wave_max(float v) {
    v = fmaxf(v, SWZ(v, 0x041f)); v = fmaxf(v, SWZ(v, 0x081f)); v = fmaxf(v, SWZ(v, 0x101f)); v = fmaxf(v, SWZ(v, 0x201f)); v = fmaxf(v, SWZ(v, 0x401f)); return xor32_max(v);
}

namespace pg8 {
constexpr int BM = 256, BK = 64, HALF = 128, HTB = HALF * BK * 2, STAGE_BYTES = 8 * HTB, NXCD = 8, WGM = 8;
__host__ __device__ __forceinline__ int lds_byte(int r, int c) { const int st = (r >> 4) * 2 + (c >> 5), rr = r & 15, cc = c & 31, ob = rr * 64 + cc * 2; return st * 1024 + (ob ^ (((ob >> 9) & 1) << 5)); }
__host__ __device__ __forceinline__ void stage_rc(int b, int& R, int& C) { const int st = b / 1024, sb = b % 1024, swz = sb ^ (((sb >> 9) & 1) << 5); R = (st >> 1) * 16 + swz / 64; C = (st & 1) * 32 + (swz % 64) / 2; }

__host__ __device__ __forceinline__ int perm32(int rho) { const int n = rho >> 4, i = rho & 15; return 8 * (i >> 2) + 4 * n + (i & 3); }
struct Unit { int pm, pn, z, k0, nt, split; };
struct Gemm { const bf16_t* A; const bf16_t* Bt; int K, lda, ldb; size_t sAz, sBz; };

struct Order {
    int nM, nN, nwg, tot, G, c, ntK, nsplit, nMfull;
    __device__ void init(int nM_, int nN_, int nZ_, int G_, int c_, int ntK_) { nM = nM_; nN = nN_; nwg = nM_ * nN_; tot = nwg * nZ_; G = G_; c = c_; ntK = ntK_; nsplit = 0; nMfull = nM_; }
    __device__ void init_split(int nMfull_, int nMtail, int nN_, int G_, int c_, int ntK_) { nM = nMfull_; nN = nN_; nwg = nMfull_ * nN_; nsplit = ntK_ / 4; tot = nwg + nMtail * nN_ * nsplit; G = G_; c = c_; ntK = ntK_; nMfull = nMfull_; }
    __device__ bool next(int i, Unit& u) const {
        const long L = (long)i * G + c; if (c < 0 || L >= tot) return false;
        if (nsplit > 0 && L >= nwg) { const int r = (int)L - nwg, su = r / nsplit, sp = r % nsplit; u.pm = nMfull + su / nN; u.pn = su % nN; u.z = 0; u.k0 = sp * 256; u.nt = 4; u.split = 1; return true; }
        const int z = (int)(L / nwg); int wgid = (int)(L % nwg);
        { const int q = nwg / NXCD, r = nwg % NXCD, xcd = wgid % NXCD, off = wgid / NXCD; wgid = (xcd < r ? xcd * (q + 1) : r * (q + 1) + (xcd - r) * q) + off; }
        const int nig = WGM * nN, gid = wgid / nig, fm = gid * WGM, gsz = (nM - fm) < WGM ? (nM - fm) : WGM;
        u.pm = fm + ((wgid % nig) % gsz); u.pn = (wgid % nig) / gsz; u.z = z; u.k0 = 0; u.nt = ntK; u.split = 0; return true;
    }
};

template <class Epi, bool ALIGN_EPI>
__device__ __forceinline__ void gemm_phase(LAS unsigned char* lds, const Gemm g, const Order& S, const Epi& E, const int wave_id) {
    int lane; asm volatile("v_mbcnt_lo_u32_b32 %0, -1, 0\n\tv_mbcnt_hi_u32_b32 %0, -1, %0" : "=v"(lane));
    int wid = wave_id; asm volatile("" : "+s"(wid)); const int tid = wid * 64 + lane, wr = wid >> 2, wc = wid & 3, fr = lane & 15, fq = lane >> 4;
    unsigned voffA[2], voffB[2];
#pragma unroll
    for (int i = 0; i < 2; ++i) { int R, C; stage_rc(tid * 16 + i * 8192, R, C); const int Rb = Epi::PERM ? ((R & ~31) + perm32(R & 31)) : R; voffA[i] = (unsigned)(R * g.lda + C) * 2u; voffB[i] = (unsigned)(Rb * g.ldb + C) * 2u; }
    const size_t kstep = (size_t)(BK * 2);
    const size_t hstepA = (size_t)HALF * g.lda * 2, hstepB = (size_t)HALF * g.ldb * 2;
    const unsigned ldsw = (unsigned)wid * 1024u;
    const int aoff = lds_byte(wr * 64 + fr, fq * 8), boff = lds_byte(wc * 32 + fr, fq * 8);
#define PG8_SA(b, h) (((b) * 2 + (h)) * HTB)
#define PG8_SB(b, h) ((4 + (b) * 2 + (h)) * HTB)
#define PG8_STAGE(bufoff, gbase, voff) do { _Pragma("unroll") for (int _i = 0; _i < 2; ++_i) \
        __builtin_amdgcn_global_load_lds((const unsigned*)((const char*)(gbase) + (voff)[_i]), (LAS unsigned*)(lds + (bufoff) + ldsw + _i * 8192), 16, 0, 0); } while (0)
#define PG8_LDA(dst, b, h) do { _Pragma("unroll") for (int m = 0; m < 4; ++m) _Pragma("unroll") for (int k = 0; k < 2; ++k) dst[m][k] = *(const LAS bf16x8*)(lds + PG8_SA(b, h) + aoff + m * 2048 + k * 1024); } while (0)
#define PG8_LDB(dst, b, h) do { _Pragma("unroll") for (int n = 0; n < 2; ++n) _Pragma("unroll") for (int k = 0; k < 2; ++k) dst[n][k] = *(const LAS bf16x8*)(lds + PG8_SB(b, h) + boff + n * 2048 + k * 1024); } while (0)
#define PG8_MMA(ai, bj, At, Bt) do { __builtin_amdgcn_s_setprio(1); _Pragma("unroll") for (int m = 0; m < 4; ++m) _Pragma("unroll") for (int n = 0; n < 2; ++n) _Pragma("unroll") for (int k = 0; k < 2; ++k) \
        acc[ai][bj][m][n] = __builtin_amdgcn_mfma_f32_16x16x32_bf16(Bt[n][k], At[m][k], acc[ai][bj][m][n], 0, 0, 0); __builtin_amdgcn_s_setprio(0); } while (0)
#define PG8_WAIT_V(n) asm volatile("s_waitcnt vmcnt(" #n ")" ::: "memory")
#define PG8_WAIT_L(n) asm volatile("s_waitcnt lgkmcnt(" #n ")" ::: "memory")
#define PG8_BAR __builtin_amdgcn_s_barrier()
#define PG8_SCHED __builtin_amdgcn_sched_barrier(0)
    Unit cur, nxt; int ui = 0;
    if (!S.next(0, cur)) return;
    f32x4 acc[2][2][4][2];
#pragma unroll
    for (int a = 0; a < 2; ++a)
#pragma unroll
        for (int b = 0; b < 2; ++b)
#pragma unroll
            for (int m = 0; m < 4; ++m)
#pragma unroll
                for (int n = 0; n < 2; ++n) acc[a][b][m][n] = (f32x4){0.f, 0.f, 0.f, 0.f};
    bf16x8 At[4][2], B0[2][2], B1[2][2];
    const char* cA = (const char*)g.A + (size_t)cur.z * g.sAz + (size_t)cur.pm * 2 * hstepA + (size_t)cur.k0 * 2; const char* cB = (const char*)g.Bt + (size_t)cur.z * g.sBz + (size_t)cur.pn * 2 * hstepB + (size_t)cur.k0 * 2;
    PG8_STAGE(PG8_SB(0, 0), cB, voffB); PG8_STAGE(PG8_SB(0, 1), cB + hstepB, voffB); PG8_STAGE(PG8_SA(0, 0), cA, voffA); PG8_STAGE(PG8_SA(0, 1), cA + hstepA, voffA);
    if (wr == 1) PG8_BAR;
    PG8_WAIT_V(2); PG8_BAR;
    PG8_STAGE(PG8_SB(1, 0), cB + kstep, voffB); PG8_STAGE(PG8_SA(1, 0), cA + kstep, voffA); PG8_STAGE(PG8_SB(1, 1), cB + hstepB + kstep, voffB);
    PG8_WAIT_V(6); PG8_BAR;
    for (;;) {
        const bool has_next = S.next(ui + 1, nxt);
        const char* nA = has_next ? (const char*)g.A + (size_t)nxt.z * g.sAz + (size_t)nxt.pm * 2 * hstepA + (size_t)nxt.k0 * 2 : cA;
        const char* nB = has_next ? (const char*)g.Bt + (size_t)nxt.z * g.sBz + (size_t)nxt.pn * 2 * hstepB + (size_t)nxt.k0 * 2 : cB;
        const int nt = cur.nt;
        for (int t = 0; t < nt; t += 2) {
            const bool last = (t == nt - 2);
            const char* a1 = cA + (size_t)(t + 1) * kstep;
            const char* a2 = last ? nA : cA + (size_t)(t + 2) * kstep; const char* b2 = last ? nB : cB + (size_t)(t + 2) * kstep;
            const char* a3 = a2 + kstep; const char* b3 = b2 + kstep;
            PG8_LDB(B0, 0, 0); PG8_LDB(B1, 0, 1); PG8_SCHED; PG8_LDA(At, 0, 0); PG8_STAGE(PG8_SA(1, 1), a1 + hstepA, voffA);
            PG8_WAIT_V(8); PG8_WAIT_L(0); PG8_BAR; PG8_MMA(0, 0, At, B0); PG8_MMA(0, 1, At, B1); PG8_BAR; PG8_SCHED;
            PG8_LDA(At, 0, 1); PG8_STAGE(PG8_SB(0, 0), b2, voffB); PG8_STAGE(PG8_SB(0, 1), b2 + hstepB, voffB); PG8_STAGE(PG8_SA(0, 0), a2, voffA);
            PG8_WAIT_V(8); PG8_WAIT_L(0); PG8_BAR; PG8_MMA(1, 0, At, B0); PG8_MMA(1, 1, At, B1); PG8_BAR; PG8_SCHED;
            PG8_LDB(B0, 1, 0); PG8_LDB(B1, 1, 1); PG8_SCHED; PG8_LDA(At, 1, 0); PG8_STAGE(PG8_SA(0, 1), a2 + hstepA, voffA);
            PG8_WAIT_V(8); PG8_WAIT_L(0); PG8_BAR; PG8_MMA(0, 0, At, B0); PG8_MMA(0, 1, At, B1); PG8_BAR; PG8_SCHED;
            PG8_LDA(At, 1, 1); PG8_STAGE(PG8_SB(1, 0), b3, voffB); PG8_STAGE(PG8_SB(1, 1), b3 + hstepB, voffB); PG8_STAGE(PG8_SA(1, 0), a3, voffA);
            PG8_WAIT_V(8); PG8_WAIT_L(0); PG8_BAR; PG8_MMA(1, 0, At, B0); PG8_MMA(1, 1, At, B1); PG8_BAR; PG8_SCHED;
        }
        if constexpr (ALIGN_EPI) { if (wr == 0) PG8_BAR; }
        if constexpr (!Epi::AFTER_DRAIN) { int fr_e = fr, fq_e = fq; asm volatile("" : "+v"(fr_e), "+v"(fq_e)); E(acc, cur, wr, wc, fr_e, fq_e); }
        if (!has_next) break;
#pragma unroll
        for (int a = 0; a < 2; ++a)
#pragma unroll
            for (int b = 0; b < 2; ++b)
#pragma unroll
                for (int m = 0; m < 4; ++m)
#pragma unroll
                    for (int n = 0; n < 2; ++n) acc[a][b][m][n] = (f32x4){0.f, 0.f, 0.f, 0.f};
        cur = nxt; cA = nA; cB = nB; ++ui;
        if constexpr (ALIGN_EPI) { if (wr == 1) PG8_BAR; }
    }
    PG8_WAIT_V(0);
    if constexpr (!ALIGN_EPI) { if (wr == 0) PG8_BAR; }
    PG8_BAR;
    if constexpr (Epi::AFTER_DRAIN) { E.fused(acc, cur, wr, wc, fr, fq, lds, wid, lane); }
#undef PG8_SA
#undef PG8_SB
#undef PG8_STAGE
#undef PG8_LDA
#undef PG8_LDB
#undef PG8_MMA
#undef PG8_WAIT_V
#undef PG8_WAIT_L
#undef PG8_BAR
#undef PG8_SCHED
}
}
using pg8::Unit;
typedef f32x4 Acc[2][2][4][2];

__device__ __forceinline__ int mod_row(int row) { return row < MP ? (row >> 12) : NPB + ((row - MP) >> 2); }

struct EpiMod {
    static constexpr bool AFTER_DRAIN = false, PERM = false;
    float* mod; const float* bmod;
    __device__ __forceinline__ void operator()(const Acc& acc, const Unit& u, int wr, int wc, int fr, int fq) const {
#pragma unroll
        for (int ai = 0; ai < 2; ++ai)
#pragma unroll
            for (int m = 0; m < 4; ++m) { const int row = ai * 128 + wr * 64 + m * 16 + fr;
                if (row < NMODROWS) {
#pragma unroll
                    for (int bj = 0; bj < 2; ++bj)
#pragma unroll
                        for (int n = 0; n < 2; ++n) { const int col = u.pn * 256 + bj * 128 + wc * 32 + n * 16 + fq * 4;
                            const f32x4 b = *(const f32x4*)(bmod + (size_t)u.z * 6144 + col);
                            *(f32x4*)(mod + ((size_t)u.z * NMODROWS + row) * 6144 + col) = acc[ai][bj][m][n] + b; } } }
    }
};

struct EpiIn {
    static constexpr bool AFTER_DRAIN = false, PERM = false;
    bf16_t *Q, *Kb, *Vb, *ZUT, *VC; float* ZUS; const float* rope;
    float* out; int l;
    __device__ __forceinline__ void operator()(const Acc& acc, const Unit& u, int wr, int wc, int fr, int fq) const {
#pragma unroll
        for (int ai = 0; ai < 2; ++ai)
#pragma unroll
            for (int m = 0; m < 4; ++m) {
                const int row = u.pm * 256 + ai * 128 + wr * 64 + m * 16 + fr;
                const bool samp = row >= MP; const int rs = row - MP;
                const int b = samp ? (rs >> 2) : (row >> 12), t = samp ? (rs & 3) : (row & 4095);
                const float* rp = rope + (size_t)(samp ? 4096 + t : t) * 64;
                if (u.pn <= 1) {
#pragma unroll
                    for (int n = 0; n < 2; ++n) { const int d = n * 16 + fq * 4;
                        const f32x4 cs = *(const f32x4*)(rp + d), sn = *(const f32x4*)(rp + 32 + d);
                        const f32x4 x1 = acc[ai][0][m][n], x2 = acc[ai][1][m][n];
                        const f32x4 o1 = (x1 * cs - x2 * sn) * 0.125f, o2 = (x2 * cs + x1 * sn) * 0.125f;
                        bf16_t* qp = Q + (size_t)row * 512 + (u.pn * 4 + wc) * 64 + d;
                        *(u32x2*)qp = (u32x2){cvt_pk_bf16(o1[0], o1[1]), cvt_pk_bf16(o1[2], o1[3])};
                        *(u32x2*)(qp + 32) = (u32x2){cvt_pk_bf16(o2[0], o2[1]), cvt_pk_bf16(o2[2], o2[3])}; }
                } else if (u.pn == 2) {
                    const bool keep = samp || t >= SEQ - 128;
                    const size_t orow = samp ? ((size_t)b * 128 + 124 + t) : ((size_t)b * 128 + (t - (SEQ - 128)));
                    const size_t okoff = samp ? (O_KS + (size_t)l * 2097152) : (O_KP + (size_t)l * 65536), ovoff = samp ? (O_VS + (size_t)l * 2097152) : (O_VP + (size_t)l * 65536);
                    if (wc < 2) {
#pragma unroll
                        for (int n = 0; n < 2; ++n) { const int d = n * 16 + fq * 4;
                            const f32x4 cs = *(const f32x4*)(rp + d), sn = *(const f32x4*)(rp + 32 + d);
                            const f32x4 x1 = acc[ai][0][m][n], x2 = acc[ai][1][m][n];
                            const f32x4 o1 = x1 * cs - x2 * sn, o2 = x2 * cs + x1 * sn;
                            bf16_t* kp = Kb + (size_t)row * 128 + wc * 64 + d;
                            *(u32x2*)kp = (u32x2){cvt_pk_bf16(o1[0], o1[1]), cvt_pk_bf16(o1[2], o1[3])};
                            *(u32x2*)(kp + 32) = (u32x2){cvt_pk_bf16(o2[0], o2[1]), cvt_pk_bf16(o2[2], o2[3])};
                            if (keep) { float* op = out + okoff + (orow * 2 + wc) * 64 + d; *(f32x4*)op = o1; *(f32x4*)(op + 32) = o2; } }
                    } else {
#pragma unroll
                        for (int bj = 0; bj < 2; ++bj)
#pragma unroll
                            for (int n = 0; n < 2; ++n) { const int d = (wc - 2) * 32 + n * 16 + fq * 4; const f32x4 v = acc[ai][bj][m][n];
                                *(u32x2*)(Vb + (size_t)row * 128 + bj * 64 + d) = (u32x2){cvt_pk_bf16(v[0], v[1]), cvt_pk_bf16(v[2], v[3])};
                                if (keep) *(f32x4*)(out + ovoff + (orow * 2 + bj) * 64 + d) = v; }
                    }
                } else if (u.pn == 3) {
#pragma unroll
                    for (int bj = 0; bj < 2; ++bj)
#pragma unroll
                        for (int n = 0; n < 2; ++n) { const int col = bj * 128 + wc * 32 + n * 16 + fq * 4; const f32x4 v = acc[ai][bj][m][n];
                            if (samp) *(f32x4*)(ZUS + (size_t)rs * 256 + col) = v;
                            else *(u32x2*)(ZUT + ((size_t)(col >> 4) * NCHUNK + (row >> 4)) * KY + (row & 15) * 16 + (col & 15)) = (u32x2){cvt_pk_bf16(v[0], v[1]), cvt_pk_bf16(v[2], v[3])}; }
                } else {
                    const bool keep = samp || t >= SEQ - 30;
                    const size_t orow = samp ? ((size_t)b * 30 + 26 + t) : ((size_t)b * 30 + (t - (SEQ - 30)));
                    const size_t ocoff = samp ? (O_CS + (size_t)l * 983040) : (O_CP + (size_t)l * 30720);
#pragma unroll
                    for (int n = 0; n < 2; ++n) { const int ch = (u.pn - 4) * 128 + wc * 32 + n * 16 + fq * 4;
                        const f32x4 za = acc[ai][0][m][n], zg = acc[ai][1][m][n]; f32x4 v;
#pragma unroll
                        for (int i = 0; i < 4; ++i) v[i] = za[i] * sigmoidf_(zg[i]);
                        *(u32x2*)(VC + (size_t)row * 256 + ch) = (u32x2){cvt_pk_bf16(v[0], v[1]), cvt_pk_bf16(v[2], v[3])};
                        if (keep) *(f32x4*)(out + ocoff + orow * 256 + ch) = v; }
                }
            }
    }
};

struct EpiE {
    static constexpr bool AFTER_DRAIN = true, PERM = false;
    bf16_t* ZUT; const float* apow;
    float *ore, *oim;
    __device__ __forceinline__ void fused(const Acc& acc, const Unit& u, int wr, int wc, int fr, int fq, LAS unsigned char* lds, int wid, int lane) const {
        LAS float* Es = (LAS float*)lds;
#pragma unroll
        for (int ai = 0; ai < 2; ++ai)
#pragma unroll
            for (int m = 0; m < 4; ++m)
#pragma unroll
                for (int n = 0; n < 2; ++n) { const int r = ai * 128 + wr * 64 + m * 16 + fr, c = wc * 32 + n * 16 + fq * 4; *(LAS f32x4*)(Es + r * 128 + c) = acc[ai][0][m][n]; }
        __syncthreads();
        if (wid == 0) {
            const int g = u.z, b = u.pm, p = lane;
            const float ar = apow[((g * 17 + 16) * 64 + p) * 2], aim = apow[((g * 17 + 16) * 64 + p) * 2 + 1];
            float hr = 0.f, hi = 0.f;
            bf16_t* zp = ZUT + ((size_t)g * NCHUNK + (size_t)b * 256) * KY + 256 + p;
            float er = Es[p], ei = Es[64 + p];
            for (int j = 0; j < 256; ++j) {
                zp[(size_t)j * KY] = f2bf(hr); zp[(size_t)j * KY + 64] = f2bf(hi);
                const int jn = j < 255 ? j + 1 : 255; const float ern = Es[jn * 128 + p], ein = Es[jn * 128 + 64 + p];
                const float nr = ar * hr - aim * hi + er, ni = ar * hi + aim * hr + ei; hr = nr; hi = ni; er = ern; ei = ein;
            }
            ore[(b * 16 + g) * 64 + p] = hr; oim[(b * 16 + g) * 64 + p] = hi;
        }
        __syncthreads();
    }
};

struct EpiY {
    static constexpr bool AFTER_DRAIN = false, PERM = false;
    bf16_t* Z;
    __device__ __forceinline__ void operator()(const Acc& acc, const Unit& u, int wr, int wc, int fr, int fq) const {
#pragma unroll
        for (int ai = 0; ai < 2; ++ai)
#pragma unroll
            for (int m = 0; m < 4; ++m) { const int crow = u.pm * 256 + ai * 128 + wr * 64 + m * 16 + fr;
#pragma unroll
                for (int bj = 0; bj < 2; ++bj)
#pragma unroll
                    for (int n = 0; n < 2; ++n) { const int col = bj * 128 + wc * 32 + n * 16 + fq * 4, t = col >> 4, cp = col & 15; const f32x4 v = acc[ai][bj][m][n];
                        *(u32x2*)(Z + ((size_t)crow * 16 + t) * 256 + u.z * 16 + cp) = (u32x2){cvt_pk_bf16(gelu_tanh(v[0]), gelu_tanh(v[1])), cvt_pk_bf16(gelu_tanh(v[2]), gelu_tanh(v[3]))}; } }
    }
};

struct EpiGlu {
    static constexpr bool AFTER_DRAIN = false, PERM = false;
    const bf16_t* Z; bf16_t* MIX; const float* bglu;
    __device__ __forceinline__ void operator()(const Acc& acc, const Unit& u, int wr, int wc, int fr, int fq) const {
#pragma unroll
        for (int ai = 0; ai < 2; ++ai)
#pragma unroll
            for (int m = 0; m < 4; ++m) { const int row = u.pm * 256 + ai * 128 + wr * 64 + m * 16 + fr;
#pragma unroll
                for (int bj = 0; bj < 2; ++bj)
#pragma unroll
                    for (int n = 0; n < 2; ++n) { const int col = bj * 128 + wc * 32 + n * 16 + fq * 4; const f32x4 a = acc[ai][bj][m][n] + *(const f32x4*)(bglu + col);
                        const u32x2 zw = *(const u32x2*)(Z + (size_t)row * 256 + col);
                        const float o0 = bflo(zw.x) * sigmoidf_(a[0]), o1 = bfhi(zw.x) * sigmoidf_(a[1]), o2 = bflo(zw.y) * sigmoidf_(a[2]), o3 = bfhi(zw.y) * sigmoidf_(a[3]);
                        *(u32x2*)(MIX + (size_t)row * 1024 + 512 + col) = (u32x2){cvt_pk_bf16(o0, o1), cvt_pk_bf16(o2, o3)}; } }
    }
};

struct EpiRes {
    static constexpr bool AFTER_DRAIN = false, PERM = false;
    const float *xp, *xs;
    float* X; const float* gate; float* part;
    __device__ __forceinline__ void operator()(const Acc& acc, const Unit& u, int wr, int wc, int fr, int fq) const {
#pragma unroll
        for (int ai = 0; ai < 2; ++ai)
#pragma unroll
            for (int m = 0; m < 4; ++m) { const int row = u.pm * 256 + ai * 128 + wr * 64 + m * 16 + fr;
                const float* base = xp ? (row < MP ? xp + (size_t)row * D : xs + (size_t)(row - MP) * D) : X + (size_t)row * D;
                const float* gp = gate + (size_t)mod_row(row) * 6144;
#pragma unroll
                for (int bj = 0; bj < 2; ++bj)
#pragma unroll
                    for (int n = 0; n < 2; ++n) { const int col = u.pn * 256 + bj * 128 + wc * 32 + n * 16 + fq * 4;
                        const f32x4 ga = *(const f32x4*)(gp + col) * acc[ai][bj][m][n];
                        if (u.split) { *(u32x2*)((bf16_t*)part + ((size_t)(u.k0 >> 8) * MS + (row - MP)) * D + col) = (u32x2){cvt_pk_bf16(ga[0], ga[1]), cvt_pk_bf16(ga[2], ga[3])};
                        } else *(f32x4*)(X + (size_t)row * D + col) = *(const f32x4*)(base + col) + ga; } }
    }
};

struct EpiGU {
    static constexpr bool AFTER_DRAIN = false, PERM = true;
    bf16_t* H;
    __device__ __forceinline__ void operator()(const Acc& acc, const Unit& u, int wr, int wc, int fr, int fq) const {
#pragma unroll
        for (int ai = 0; ai < 2; ++ai)
#pragma unroll
            for (int m = 0; m < 4; ++m) { const int row = u.pm * 256 + ai * 128 + wr * 64 + m * 16 + fr;
                const int col = u.pn * 128 + wc * 32 + fq * 8; u32x4 w;
#pragma unroll
                for (int n = 0; n < 2; ++n) { const f32x4 g = acc[ai][0][m][n], up = acc[ai][1][m][n]; f32x4 h;
#pragma unroll
                    for (int i = 0; i < 4; ++i) h[i] = g[i] * sigmoidf_(g[i]) * up[i];
                    w[2 * n] = cvt_pk_bf16(h[0], h[1]); w[2 * n + 1] = cvt_pk_bf16(h[2], h[3]); }
                *(u32x4*)(H + (size_t)row * DFF + col) = w; }
    }
};

struct Params { const float* in[34]; float* out; unsigned char* ws; int ph_lo, ph_hi; };

__device__ __forceinline__ void transpose_item(const float* W, int K, int N, bf16_t* WT, int n0, int k0, int drow0, float* scr, int lane) {
    float wreg[32];
#pragma unroll
    for (int i = 0; i < 32; ++i) wreg[i] = W[(size_t)(k0 + 2 * i + (lane >> 5)) * N + n0 + (lane & 31)];
#pragma unroll
    for (int i = 0; i < 32; ++i) { const int kk = 2 * i + (lane >> 5); scr[kk * 33 + (lane & 31)] = wreg[i]; }
    asm volatile("s_waitcnt lgkmcnt(0)" ::: "memory");
    const int c = lane & 7;
#pragma unroll
    for (int j = 0; j < 4; ++j) { const int n = (lane >> 3) + 8 * j; const float* s = scr + (8 * c) * 33 + n;
        u32x4 o; o.x = cvt_pk_bf16(s[0 * 33], s[1 * 33]); o.y = cvt_pk_bf16(s[2 * 33], s[3 * 33]); o.z = cvt_pk_bf16(s[4 * 33], s[5 * 33]); o.w = cvt_pk_bf16(s[6 * 33], s[7 * 33]);
        *(u32x4*)(WT + (size_t)(drow0 + n) * K + k0 + 8 * c) = o; }
    asm volatile("s_waitcnt lgkmcnt(0)" ::: "memory");
}
__device__ __forceinline__ int win_dst_row(int c) {
    if (c < 512) { const int tile = c >> 8, cc = c & 255; return tile * 256 + 128 * ((cc & 63) >> 5) + 32 * (cc >> 6) + (cc & 31); }
    if (c < 640) { const int cc = c - 512; return 512 + 128 * ((cc & 63) >> 5) + 32 * (cc >> 6) + (cc & 31); }
    if (c < 768) { const int cc = c - 640; return 512 + 128 * (cc >> 6) + 64 + (cc & 63); }
    if (c < 1024) return c;
    if (c < 1280) { const int cc = c - 1024; return 1024 + 256 * (cc >> 7) + (cc & 127); }
    { const int cc = c - 1280; return 1024 + 256 * (cc >> 7) + 128 + (cc & 127); }
}

template <bool FINAL>
__device__ __forceinline__ void norm_rows(const float* xp, const float* xs, const float* X, const float* g, const float* sh, const float* sc, bf16_t* XN, float* out, int gw, int NGW, int lane, const float* part, int nsplit) {
    f32x4 vnext[4];
    if (gw < M) { const float* xr0 = xp ? (gw < MP ? xp + (size_t)gw * D : xs + (size_t)(gw - MP) * D) : X + (size_t)gw * D;
#pragma unroll
        for (int j = 0; j < 4; ++j) vnext[j] = *(const f32x4*)(xr0 + 4 * lane + 256 * j); }
    for (int row = gw; row < M; row += NGW) {
        f32x4 v[4]; float s = 0.f;
#pragma unroll
        for (int j = 0; j < 4; ++j) v[j] = vnext[j];
        { const int rn = row + NGW; if (rn < M) { const float* xrn = xp ? (rn < MP ? xp + (size_t)rn * D : xs + (size_t)(rn - MP) * D) : X + (size_t)rn * D;
#pragma unroll
            for (int j = 0; j < 4; ++j) vnext[j] = *(const f32x4*)(xrn + 4 * lane + 256 * j); } }
        if (nsplit > 0 && row >= MP) {
            for (int sp = 0; sp < nsplit; ++sp) { const bf16_t* pr = (const bf16_t*)part + ((size_t)sp * MS + (row - MP)) * D + 4 * lane;
#pragma unroll
                for (int j = 0; j < 4; ++j) { const u32x2 w = *(const u32x2*)(pr + 256 * j); v[j] += (f32x4){bflo(w.x), bfhi(w.x), bflo(w.y), bfhi(w.y)}; } }
#pragma unroll
            for (int j = 0; j < 4; ++j) *(f32x4*)((float*)X + (size_t)row * D + 4 * lane + 256 * j) = v[j]; }
#pragma unroll
        for (int j = 0; j < 4; ++j) s += (v[j][0] * v[j][0] + v[j][1] * v[j][1]) + (v[j][2] * v[j][2] + v[j][3] * v[j][3]);
        const float rstd = 1.0f / sqrtf(wave_sum(s) * (1.0f / D) + EPS);
        const int mr = mod_row(row);
        if (!FINAL && xp && row >= MP) {
#pragma unroll
            for (int j = 0; j < 4; ++j) *(f32x4*)((float*)X + (size_t)row * D + 4 * lane + 256 * j) = v[j]; }
#pragma unroll
        for (int j = 0; j < 4; ++j) { const int col = 4 * lane + 256 * j; const f32x4 gg = *(const f32x4*)(g + col);
            if (FINAL) { *(f32x4*)(out + (size_t)row * D + col) = v[j] * rstd * gg; }
            else { const f32x4 s1 = *(const f32x4*)(sc + (size_t)mr * 6144 + col), s0 = *(const f32x4*)(sh + (size_t)mr * 6144 + col);
                const f32x4 h = v[j] * rstd * gg * (s1 + 1.0f) + s0;
                *(u32x2*)(XN + (size_t)row * D + col) = (u32x2){cvt_pk_bf16(h[0], h[1]), cvt_pk_bf16(h[2], h[3])}; } }
    }
}

constexpr int KS_PITCH = 144, VT_PITCH = 528, ATT_KS = 0, ATT_VT = 256 * KS_PITCH;
__device__ __forceinline__ void attn_prompt_unit(unsigned char* lds, const bf16_t* Q, const bf16_t* Kb, const bf16_t* Vb, bf16_t* MIX, const float* sinks, int unit, int tid) {
    const int kvh = unit & 1, nb = (unit >> 1) & 31, b = unit >> 6;
    const int wid = tid >> 6, lane = tid & 63;
    __syncthreads();
#pragma unroll
    for (int i = 0; i < 4; ++i) { const int ch = tid + 512 * i, kj = ch >> 3, c8 = ch & 7; const int tok = nb * 128 - 128 + kj;
        u32x4 kv = (u32x4){0u, 0u, 0u, 0u}, vv = kv;
        if (tok >= 0) { const size_t off = ((size_t)b * SEQ + tok) * 128 + kvh * 64 + c8 * 8; kv = *(const u32x4*)(Kb + off); vv = *(const u32x4*)(Vb + off); }
        *(u32x4*)(lds + ATT_KS + kj * KS_PITCH + c8 * 16) = kv;
        bf16_t* vt = (bf16_t*)(lds + ATT_VT) + kj;
#pragma unroll
        for (int j = 0; j < 4; ++j) { const unsigned w = vv[j]; vt[(size_t)(c8 * 8 + 2 * j) * (VT_PITCH / 2)] = (bf16_t)(w & 0xffffu); vt[(size_t)(c8 * 8 + 2 * j + 1) * (VT_PITCH / 2)] = (bf16_t)(w >> 16); } }
    __syncthreads();
    const int g = wid & 3, hh = wid >> 2, head = kvh * 4 + g, l32 = lane & 31, hi = lane >> 5;
    const float sink = sinks[head];
#pragma unroll 1
    for (int qs = 0; qs < 2; ++qs) {
        const int q0 = 64 * hh + 32 * qs, qi = q0 + l32;
        const size_t qrow = (size_t)b * SEQ + nb * 128 + qi;
        bf16x8 qf[4];
#pragma unroll
        for (int ks = 0; ks < 4; ++ks) qf[ks] = *(const bf16x8*)(Q + qrow * 512 + head * 64 + ks * 16 + hi * 8);
        f32x16 S[5];
#pragma unroll
        for (int kb = 0; kb < 5; ++kb) { f32x16 a = {0.f,0.f,0.f,0.f,0.f,0.f,0.f,0.f,0.f,0.f,0.f,0.f,0.f,0.f,0.f,0.f};
            const unsigned char* kp = lds + ATT_KS + (q0 + 32 * kb + l32) * KS_PITCH + hi * 16;
#pragma unroll
            for (int ks = 0; ks < 4; ++ks) { const bf16x8 kf = *(const bf16x8*)(kp + ks * 32); a = __builtin_amdgcn_mfma_f32_32x32x16_bf16(kf, qf[ks], a, 0, 0, 0); }
            S[kb] = a; }
        float mx = -1e30f;
#pragma unroll
        for (int kb = 0; kb < 5; ++kb)
#pragma unroll
            for (int r = 0; r < 16; ++r) { const int kj = q0 + 32 * kb + (r & 3) + 8 * (r >> 2) + 4 * hi; const int rel = 128 + qi - kj;
                const bool ok = (rel >= 0) && (rel < 128) && (nb > 0 || kj >= 128);
                const float s = ok ? S[kb][r] : -1e30f; S[kb][r] = s; mx = fmaxf(mx, s); }
        mx = fmaxf(xor32_max(mx), sink);
        float sum = 0.f;
#pragma unroll
        for (int kb = 0; kb < 5; ++kb)
#pragma unroll
            for (int r = 0; r < 16; ++r) { const float e = __expf(S[kb][r] - mx); S[kb][r] = e; sum += e; }
        sum = xor32_sum(sum) + __expf(sink - mx);
        const float inv = 1.0f / sum;
        bf16x8 P[5][2];
#pragma unroll
        for (int kb = 0; kb < 5; ++kb)
#pragma unroll
            for (int sl = 0; sl < 2; ++sl) { u32x4 w;
                w.x = cvt_pk_bf16(S[kb][8 * sl + 0] * inv, S[kb][8 * sl + 1] * inv); w.y = cvt_pk_bf16(S[kb][8 * sl + 2] * inv, S[kb][8 * sl + 3] * inv);
                w.z = cvt_pk_bf16(S[kb][8 * sl + 4] * inv, S[kb][8 * sl + 5] * inv); w.w = cvt_pk_bf16(S[kb][8 * sl + 6] * inv, S[kb][8 * sl + 7] * inv);
                P[kb][sl] = __builtin_bit_cast(bf16x8, w); }
#pragma unroll
        for (int db = 0; db < 2; ++db) { f32x16 o = {0.f,0.f,0.f,0.f,0.f,0.f,0.f,0.f,0.f,0.f,0.f,0.f,0.f,0.f,0.f,0.f};
            const unsigned char* vp = lds + ATT_VT + (32 * db + l32) * VT_PITCH + (q0 + 4 * hi) * 2;
#pragma unroll
            for (int kb = 0; kb < 5; ++kb)
#pragma unroll
                for (int sl = 0; sl < 2; ++sl) { const u32x2 lo = *(const u32x2*)(vp + (32 * kb + 16 * sl) * 2), hi2 = *(const u32x2*)(vp + (32 * kb + 16 * sl + 8) * 2);
                    const bf16x8 vf = __builtin_bit_cast(bf16x8, (u32x4){lo.x, lo.y, hi2.x, hi2.y});
                    o = __builtin_amdgcn_mfma_f32_32x32x16_bf16(vf, P[kb][sl], o, 0, 0, 0); }
            bf16_t* op = MIX + qrow * 1024 + head * 64 + 32 * db + 4 * hi;
#pragma unroll
            for (int r4 = 0; r4 < 4; ++r4) *(u32x2*)(op + 8 * r4) = (u32x2){cvt_pk_bf16(o[4 * r4], o[4 * r4 + 1]), cvt_pk_bf16(o[4 * r4 + 2], o[4 * r4 + 3])}; }
    }
}

__device__ __forceinline__ void attn_sample_wave(float* wl  , const bf16_t* Q, const bf16_t* Kb, const bf16_t* Vb, const float* ck, const float* cv, bf16_t* MIX, const float* sinks, int task, int lane) {
    const int g = task & 3, kvh = (task >> 2) & 1, b = task >> 3, head = kvh * 4 + g;
    float* qs = wl; float* ps = wl + 256;
#pragma unroll
    for (int t = 0; t < 4; ++t) qs[t * 64 + lane] = bf2f(Q[(size_t)(MP + b * 4 + t) * 512 + head * 64 + lane]);
    asm volatile("s_waitcnt lgkmcnt(0)" ::: "memory");
    float sc[3][4];
#pragma unroll
    for (int slot = 0; slot < 3; ++slot) {
        const int j = slot * 64 + lane; const bool have = (slot < 2) || (lane < 4);
        float d0 = 0.f, d1 = 0.f, d2 = 0.f, d3 = 0.f;
        if (have) {
            if (slot < 2) { const float* kr = ck + ((size_t)b * 128 + j) * 128 + kvh * 64;
#pragma unroll 8
                for (int d4 = 0; d4 < 16; ++d4) { const f32x4 kv = *(const f32x4*)(kr + 4 * d4);
#pragma unroll
                    for (int i = 0; i < 4; ++i) { const int d = 4 * d4 + i; d0 += kv[i] * qs[d]; d1 += kv[i] * qs[64 + d]; d2 += kv[i] * qs[128 + d]; d3 += kv[i] * qs[192 + d]; } }
            } else { const bf16_t* kr = Kb + (size_t)(MP + b * 4 + lane) * 128 + kvh * 64;
#pragma unroll 16
                for (int d = 0; d < 64; ++d) { const float kv = bf2f(kr[d]); d0 += kv * qs[d]; d1 += kv * qs[64 + d]; d2 += kv * qs[128 + d]; d3 += kv * qs[192 + d]; } }
        }
        const float dd[4] = {d0, d1, d2, d3};
#pragma unroll
        for (int t = 0; t < 4; ++t) { const bool ok = have && ((slot < 2) ? (j > t) : (lane <= t)); sc[slot][t] = ok ? dd[t] : -1e30f; }
    }
    const float sink = sinks[head];
#pragma unroll
    for (int t = 0; t < 4; ++t) {
        float mx = fmaxf(fmaxf(sc[0][t], sc[1][t]), sc[2][t]); mx = fmaxf(wave_max(mx), sink);
        const float e0 = __expf(sc[0][t] - mx), e1 = __expf(sc[1][t] - mx), e2 = __expf(sc[2][t] - mx);
        const float sum = wave_sum(e0 + e1 + e2) + __expf(sink - mx); const float inv = 1.0f / sum;
        ps[t * 132 + lane] = e0 * inv; ps[t * 132 + 64 + lane] = e1 * inv; if (lane < 4) ps[t * 132 + 128 + lane] = e2 * inv;
    }
    asm volatile("s_waitcnt lgkmcnt(0)" ::: "memory");
    float o0 = 0.f, o1 = 0.f, o2 = 0.f, o3 = 0.f;
    const float* vr = cv + (size_t)b * 128 * 128 + kvh * 64 + lane;
#pragma unroll 1
    for (int j0 = 0; j0 < 128; j0 += 32) { float vv[32];
#pragma unroll
        for (int jj = 0; jj < 32; ++jj) vv[jj] = vr[(size_t)(j0 + jj) * 128];
#pragma unroll
        for (int jj = 0; jj < 32; ++jj) { const int j = j0 + jj; const float v = vv[jj]; o0 += ps[j] * v; o1 += ps[132 + j] * v; o2 += ps[264 + j] * v; o3 += ps[396 + j] * v; } }
#pragma unroll
    for (int j = 0; j < 4; ++j) { const float v = bf2f(Vb[(size_t)(MP + b * 4 + j) * 128 + kvh * 64 + lane]); o0 += ps[128 + j] * v; o1 += ps[132 + 128 + j] * v; o2 += ps[264 + 128 + j] * v; o3 += ps[396 + 128 + j] * v; }
    bf16_t* op = MIX + (size_t)(MP + b * 4) * 1024 + head * 64 + lane;
    op[0] = f2bf(o0); op[1024] = f2bf(o1); op[2048] = f2bf(o2); op[3072] = f2bf(o3);
    asm volatile("s_waitcnt lgkmcnt(0)" ::: "memory");
}

__device__ __forceinline__ void conv_group(const bf16_t* VC, size_t vrow0  , int tvalid0  , const float* hist,
                                           const float* cw, const float* cb, const float* lg, const float* lb, bf16_t* MIX, size_t orow0, int lane) {
    const int c4 = lane * 4;
    u32x2 vr[34];
#pragma unroll
    for (int r = 0; r < 34; ++r) {
        if (hist && r < 30) { const f32x4 h = *(const f32x4*)(hist + (size_t)r * 256 + c4); vr[r] = (u32x2){cvt_pk_bf16(h[0], h[1]), cvt_pk_bf16(h[2], h[3])}; }
        else if (r < tvalid0) vr[r] = (u32x2){0u, 0u};
        else vr[r] = *(const u32x2*)(VC + (vrow0 + r - 30) * 256 + c4);
    }
    const f32x4 bias = *(const f32x4*)(cb + c4);
    f32x4 acc[4] = {bias, bias, bias, bias};
#pragma unroll
    for (int k = 0; k < 31; ++k) { const f32x4 w = *(const f32x4*)(cw + (size_t)k * 256 + c4);
#pragma unroll
        for (int jj = 0; jj < 4; ++jj) { const u32x2 v = vr[k + jj]; acc[jj] += w * (f32x4){bflo(v.x), bfhi(v.x), bflo(v.y), bfhi(v.y)}; } }
    const f32x4 gg = *(const f32x4*)(lg + c4), bb = *(const f32x4*)(lb + c4);
#pragma unroll
    for (int jj = 0; jj < 4; ++jj) { const f32x4 a = acc[jj];
        const float mean = wave_sum((a[0] + a[1]) + (a[2] + a[3])) * (1.0f / 256.0f);
        const f32x4 dl = a - mean; const float var = wave_sum((dl[0] * dl[0] + dl[1] * dl[1]) + (dl[2] * dl[2] + dl[3] * dl[3])) * (1.0f / 256.0f);
        const float rstd = 1.0f / sqrtf(var + EPS); f32x4 y = dl * rstd * gg + bb;
#pragma unroll
        for (int i = 0; i < 4; ++i) y[i] = y[i] * sigmoidf_(y[i]);
        *(u32x2*)(MIX + (orow0 + jj) * 1024 + 768 + c4) = (u32x2){cvt_pk_bf16(y[0], y[1]), cvt_pk_bf16(y[2], y[3])}; }
}

__device__ __forceinline__ void ssm_sample_wave(float* wl  , const float* ZUS, const float* sre, const float* sim, const float* apow, const float* bbt,
                                                const float* cre, const float* cim, const float* dsk, bf16_t* Z, float* ore, float* oim, int task, int lane) {
    const int g = task & 15, b = task >> 4, p = lane;
    const float ar = apow[((g * 17 + 1) * 64 + p) * 2], aim = apow[((g * 17 + 1) * 64 + p) * 2 + 1];
    float hr = sre[((size_t)b * 16 + g) * 64 + p], hi = sim[((size_t)b * 16 + g) * 64 + p];
    const float* bp = bbt + ((size_t)g * 64 + p) * 32;
    f32x4 bpv[8];
#pragma unroll
    for (int c4 = 0; c4 < 8; ++c4) bpv[c4] = *(const f32x4*)(bp + 4 * c4);
#pragma unroll
    for (int t = 0; t < 4; ++t) { const float* u = ZUS + (size_t)(b * 4 + t) * 256 + g * 16; float br = 0.f, bi = 0.f;
#pragma unroll
        for (int c4 = 0; c4 < 4; ++c4) { const f32x4 uv = *(const f32x4*)(u + 4 * c4);
#pragma unroll
            for (int i = 0; i < 4; ++i) { const int c = 4 * c4 + i; br += bpv[c >> 1][(c & 1) * 2] * uv[i]; bi += bpv[c >> 1][(c & 1) * 2 + 1] * uv[i]; } }
        const float nr = ar * hr - aim * hi + br, ni = ar * hi + aim * hr + bi; hr = nr; hi = ni;
        wl[t * 128 + p] = hr; wl[t * 128 + 64 + p] = hi; }
    ore[((size_t)b * 16 + g) * 64 + p] = hr; oim[((size_t)b * 16 + g) * 64 + p] = hi;
    asm volatile("s_waitcnt lgkmcnt(0)" ::: "memory");
    const int t = lane >> 4, cp = lane & 15;
    const float* cr = cre + ((size_t)g * 16 + cp) * 64; const float* ci = cim + ((size_t)g * 16 + cp) * 64;
    float y = 0.f;
    f32x4 crv[16], civ[16];
#pragma unroll
    for (int q4 = 0; q4 < 16; ++q4) { crv[q4] = *(const f32x4*)(cr + 4 * q4); civ[q4] = *(const f32x4*)(ci + 4 * q4); }
#pragma unroll
    for (int q4 = 0; q4 < 16; ++q4) { const f32x4 hr4 = *(const f32x4*)(wl + t * 128 + 4 * q4), hi4 = *(const f32x4*)(wl + t * 128 + 64 + 4 * q4);
#pragma unroll
        for (int i = 0; i < 4; ++i) y += crv[q4][i] * hr4[i] - civ[q4][i] * hi4[i]; }
    y += dsk[g * 16 + cp] * ZUS[(size_t)(b * 4 + t) * 256 + g * 16 + cp];
    Z[(size_t)(MP + b * 4 + t) * 256 + g * 16 + cp] = f2bf(gelu_tanh(y));
    asm volatile("s_waitcnt lgkmcnt(0)" ::: "memory");
}

__device__ __forceinline__ const void* ld_ptr(unsigned pb, int i) { const unsigned long long v = *(const LAS unsigned long long*)(pb + 8u * (unsigned)i);
    const unsigned lo = __builtin_amdgcn_readfirstlane((unsigned)v), hi = __builtin_amdgcn_readfirstlane((unsigned)(v >> 32));
    typedef __attribute__((address_space(1))) const void* gptr_t; return (const void*)(gptr_t)(((unsigned long long)hi << 32) | lo); }
constexpr int PTAB_OFF = 131072 + 1024;
#define XB_TMO      128
#define XB_XCNT(j)  (256  + 64 * (j))
#define XB_XSUB(j)  (1280 + 64 * (j))
#define XB_XGEN(j)  (2304 + 64 * (j))
#define XB_TOP      3328
#define XB_TOPGEN   3392
#define XCD_BAR_WORDS 3456
#define XB_SPIN_CAP (1u << 20)
__device__ __forceinline__ unsigned xb_ld(unsigned* p)              { return __hip_atomic_load(p, __ATOMIC_RELAXED, __HIP_MEMORY_SCOPE_AGENT); }
__device__ __forceinline__ unsigned xb_add(unsigned* p, unsigned v) { return __hip_atomic_fetch_add(p, v, __ATOMIC_RELAXED, __HIP_MEMORY_SCOPE_AGENT); }
__device__ __forceinline__ unsigned xb_xcc_id() { return (unsigned)__builtin_amdgcn_s_getreg((3 << 11) | 20) & 0xFu; }
#define XB_SPIN(cond, bar) do { unsigned _sp = 0; while (cond) { __builtin_amdgcn_s_sleep(1); \
    if ((++_sp & 255u) == 0u) { if (xb_ld(&(bar)[XB_TMO])) break; if (_sp > XB_SPIN_CAP) { atomicAdd(&(bar)[XB_TMO], 1u); break; } } } } while (0)
constexpr int XBST_OFF = PTAB_OFF + 512;
__device__ __forceinline__ void xcd_barrier_complete(unsigned* bar, unsigned x, unsigned G, unsigned& nloc, unsigned& nx) {
    unsigned sum, cnt, mine, sp = 0u;
    for (;;) {
        sum = 0u; cnt = 0u; mine = 0u;
#pragma unroll
        for (unsigned j = 0; j < 16; ++j) { const unsigned c = xb_ld(&bar[XB_XCNT(j)]); sum += c; cnt += (c > 0u) ? 1u : 0u; mine = (j == x) ? c : mine; }
        if (sum == G) break;
        __builtin_amdgcn_s_sleep(1);
        if ((++sp & 255u) == 0u) { if (xb_ld(&bar[XB_TMO])) break; if (sp > XB_SPIN_CAP) { atomicAdd(&bar[XB_TMO], 1u); break; } }
    }
    nloc = mine > 0u ? mine : 1u; nx = cnt > 0u ? cnt : 1u;
}
__device__ __forceinline__ void grid_barrier(unsigned* bar, unsigned G, int tid, volatile LAS unsigned* st) {
    asm volatile("s_waitcnt vmcnt(0) lgkmcnt(0)" ::: "memory");
    __syncthreads();
    if (tid == 0) {
        const unsigned x = xb_xcc_id();
        unsigned nloc = st[0], nx = st[1];
        if (nloc == 0u) { xcd_barrier_complete(bar, x, G, nloc, nx); st[0] = nloc; st[1] = nx; }
        const unsigned old = xb_add(&bar[XB_XSUB(x)], 1u);
        const unsigned gen = old / nloc;
        if (old + 1u == (gen + 1u) * nloc) {
            __builtin_amdgcn_fence(__ATOMIC_RELEASE, "agent");
            asm volatile("s_waitcnt vmcnt(0)" ::: "memory");
            const unsigned og = xb_add(&bar[XB_TOP], 1u);
            const unsigned tg = og / nx;
            if (og + 1u == (tg + 1u) * nx) xb_add(&bar[XB_TOPGEN], 1u);
            else XB_SPIN(xb_ld(&bar[XB_TOPGEN]) == tg, bar);
            __builtin_amdgcn_fence(__ATOMIC_ACQUIRE, "agent");
            xb_add(&bar[XB_XGEN(x)], 1u);
            asm volatile("s_waitcnt vmcnt(0)" ::: "memory");
        } else {
            XB_SPIN(xb_ld(&bar[XB_XGEN(x)]) == gen, bar);
            __builtin_amdgcn_fence(__ATOMIC_ACQUIRE, "agent");
            asm volatile("s_waitcnt vmcnt(0)" ::: "memory");
        }
    }
    __syncthreads();
}
__global__ void __launch_bounds__(512, 2) hybrid_fwd(Params P) {
    extern __shared__ __attribute__((aligned(16))) unsigned char lds[];
    LAS unsigned char* ldsl = (LAS unsigned char*)lds;
    const int G0 = gridDim.x, bid0 = blockIdx.x;
    const int wave0 = __builtin_amdgcn_readfirstlane((int)threadIdx.x >> 6);
#if !MK_LAUNCH_PER_PHASE
    cg::this_grid().sync();
#endif
    LAS unsigned long long* ptab = (LAS unsigned long long*)(ldsl + PTAB_OFF);
    if (threadIdx.x == 0) {
#pragma unroll
        for (int i = 0; i < 34; ++i) ptab[i] = (unsigned long long)P.in[i];
        ptab[34] = (unsigned long long)P.out; ptab[35] = (unsigned long long)P.ws;
        ((volatile LAS unsigned*)(ldsl + XBST_OFF))[0] = 0u; ((volatile LAS unsigned*)(ldsl + XBST_OFF))[1] = 0u;
        (void)xb_add((unsigned*)P.ws + XB_XCNT(xb_xcc_id()), 1u); }
    __syncthreads();
#define INP(i) ((const float*)ld_ptr(pb, (i)))
#define ROPE ((float*)(ws + WS_ROPE))
#define SC ((bf16_t*)(ws + WS_SC))
#define APOW ((float*)(ws + WS_APOW))
#define BB ((float*)(ws + WS_BB))
#define MOD ((float*)(ws + WS_MOD))
#define WGLU ((bf16_t*)(ws + WS_WGLU))
#define BTE ((bf16_t*)(ws + WS_BTE))
#define BTY ((bf16_t*)(ws + WS_BTY))
#define WIN ((bf16_t*)(ws + WS_WIN))
#define WOUT ((bf16_t*)(ws + WS_WOUT))
#define WGU ((bf16_t*)(ws + WS_WGU))
#define WDN ((bf16_t*)(ws + WS_WDN))
#define X ((float*)(ws + WS_X))
#define XN ((bf16_t*)(ws + WS_XN))
#define Hb ((bf16_t*)(ws + WS_H))
#define MIX ((bf16_t*)(ws + WS_MIX))
#define Qb ((bf16_t*)(ws + WS_Q))
#define Kb ((bf16_t*)(ws + WS_K))
#define Vb ((bf16_t*)(ws + WS_V))
#define ZUT ((bf16_t*)(ws + WS_ZUT))
#define VC ((bf16_t*)(ws + WS_VC))
#define Zb ((bf16_t*)(ws + WS_Z))
#define ZUS ((float*)(ws + WS_ZUS))
#define WMOD ((bf16_t*)(ws + WS_WMOD))
    const int lo = P.ph_lo, hi = P.ph_hi;
    int ph = 0;
#define PHASE_BEGIN if (ph >= lo && ph < hi) { int lane; asm volatile("v_mbcnt_lo_u32_b32 %0, -1, 0\n\tv_mbcnt_hi_u32_b32 %0, -1, %0" : "=v"(lane)); int G = G0, bid = bid0; asm volatile("" : "+s"(G), "+s"(bid)); const int NGW = G * 8, NGT = G * 512; (void)NGW; (void)NGT; int wave = wave0; asm volatile("" : "+s"(wave)); const int tid = wave * 64 + lane, gw = bid * 8 + wave, gt = bid * 512 + tid; (void)lane; (void)gw; (void)gt; \
    unsigned pb = (unsigned)(size_t)ptab; asm volatile("" : "+v"(pb)); unsigned char* const ws = (unsigned char*)ld_ptr(pb, 35); float* const out = (float*)ld_ptr(pb, 34); (void)out;
#if MK_LAUNCH_PER_PHASE
#define PHASE_END } ++ph;
#else
#define PHASE_END if (ph + 1 < hi) grid_barrier((unsigned*)ws, (unsigned)G, tid, (volatile LAS unsigned*)(ldsl + XBST_OFF)); } ++ph;
#endif

    PHASE_BEGIN
    {
        for (int i = gt; i < 4100 * 32; i += NGT) { const int idx = i >> 5, d = i & 31; const int pos = idx < 4096 ? idx : 8192 + (idx - 4096);
            const double invf = exp(-(double)d * (9.210340371976184 / 32.0)); float c, s; cis_rev((double)pos * invf, c, s); ROPE[idx * 64 + d] = c; ROPE[idx * 64 + 32 + d] = s; }
        { const float* cpr = INP(2); const float* csm = INP(3);
        for (int i = gt; i < 256 * 1024; i += NGT) { const int r = i >> 10, c = i & 1023; float v = 0.f;
            if (r < NPB) v = cpr[r * 1024 + c]; else if (r < NMODROWS) v = csm[(r - NPB) * 1024 + c];
            SC[i] = f2bf(v * sigmoidf_(v)); } }
        for (int i = gt; i < DEPTH * 16 * 17 * 64; i += NGT) { const int p = i & 63, k = (i >> 6) % 17, lg = i / (64 * 17);
            const float dt = __expf(INP(17)[lg]); const float lr = INP(15)[lg * 64 + p], li = INP(16)[lg * 64 + p];
            const float th = li * dt; float c, s; cis_rev((double)th * (double)k, c, s); const float mag = expf((float)k * (lr * dt));
            APOW[(size_t)i * 2] = mag * c; APOW[(size_t)i * 2 + 1] = mag * s; }
        for (int i = gt; i < DEPTH * 16 * 64 * 16; i += NGT) { const int c = i & 15, p = (i >> 4) & 63, lg = i >> 10;
            const float dt = __expf(INP(17)[lg]); const float lr = INP(15)[lg * 64 + p], li = INP(16)[lg * 64 + p];
            float cc, ss; cis_rev((double)(li * dt), cc, ss); const float mag = expf(lr * dt); const float abr = mag * cc, abi = mag * ss;
            const float den = lr * lr + li * li, nr = abr - 1.0f; const float cr = (nr * lr + abi * li) / den, ci = (abi * lr - nr * li) / den;
            const float br = INP(18)[(size_t)(lg * 64 + p) * 16 + c], bi = INP(19)[(size_t)(lg * 64 + p) * 16 + c];
            BB[(size_t)i * 2] = cr * br - ci * bi; BB[(size_t)i * 2 + 1] = cr * bi + ci * br; }
        { const float* ckp = INP(4); const float* cvp = INP(5); const float* scp = INP(8);
#pragma unroll 4
        for (int i = gt; i < DEPTH * NSB * 124 * 32; i += NGT) { const int c4 = i & 31, r = (i >> 5) % 124, lb = i / (32 * 124);
            const size_t src = ((size_t)lb * 128 + r + 4) * 128 + c4 * 4, dst = ((size_t)lb * 128 + r) * 128 + c4 * 4;
            *(f32x4*)(out + O_KS + dst) = *(const f32x4*)(ckp + src); *(f32x4*)(out + O_VS + dst) = *(const f32x4*)(cvp + src); }
#pragma unroll 4
        for (int i = gt; i < DEPTH * NSB * 26 * 64; i += NGT) { const int c4 = i & 63, r = (i >> 6) % 26, lb = i / (64 * 26);
            *(f32x4*)(out + O_CS + ((size_t)lb * 30 + r) * 256 + c4 * 4) = *(const f32x4*)(scp + ((size_t)lb * 30 + r + 4) * 256 + c4 * 4); } }
        float* scr = (float*)(lds + wave * 16384);
        constexpr int I_IN = 16 * 48, I_OUT = 16 * 32, I_G = 16 * 88, I_DN = 44 * 32, I_GLU = 4 * 8, I_MOD = 16 * 192;
        constexpr int I_LAYER = I_IN + I_OUT + 2 * I_G + I_DN + I_GLU + I_MOD;
        for (int it = gw; it < DEPTH * I_LAYER; it += NGW) {
            const int l = it / I_LAYER; int r = it % I_LAYER;
            if (r < I_IN) { const int kb = r / 48, nbk = r % 48; transpose_item(INP(13) + (size_t)l * D * NIN, D, NIN, WIN + (size_t)l * NIN * D, nbk * 32, kb * 64, win_dst_row(nbk * 32), scr, lane); continue; } r -= I_IN;
            if (r < I_OUT) { const int kb = r / 32, nbk = r % 32; transpose_item(INP(29) + (size_t)l * D * D, D, D, WOUT + (size_t)l * D * D, nbk * 32, kb * 64, nbk * 32, scr, lane); continue; } r -= I_OUT;
            if (r < I_G) { const int kb = r / 88, nbk = r % 88, n0 = nbk * 32; transpose_item(INP(30) + (size_t)l * D * DFF, D, DFF, WGU + (size_t)l * NGU * D, n0, kb * 64, 256 * (n0 >> 7) + (n0 & 127), scr, lane); continue; } r -= I_G;
            if (r < I_G) { const int kb = r / 88, nbk = r % 88, n0 = nbk * 32; transpose_item(INP(31) + (size_t)l * D * DFF, D, DFF, WGU + (size_t)l * NGU * D, n0, kb * 64, 256 * (n0 >> 7) + 128 + (n0 & 127), scr, lane); continue; } r -= I_G;
            if (r < I_DN) { const int kb = r / 32, nbk = r % 32; transpose_item(INP(32) + (size_t)l * DFF * D, DFF, D, WDN + (size_t)l * D * DFF, nbk * 32, kb * 64, nbk * 32, scr, lane); continue; } r -= I_DN;
            if (r < I_GLU) { const int kb = r / 8, nbk = r % 8; transpose_item(INP(23) + (size_t)l * 65536, 256, 256, WGLU + (size_t)l * 65536, nbk * 32, kb * 64, nbk * 32, scr, lane); continue; } r -= I_GLU;
            { const int kb = r / 192, nbk = r % 192; transpose_item(INP(11) + (size_t)l * D * 6144, D, 6144, WMOD + (size_t)l * 6144 * D, nbk * 32, kb * 64, nbk * 32, scr, lane); }
        }
    }
    PHASE_END

    PHASE_BEGIN
    {
        if (bid >= 96) {
        const int gt = (bid - 96) * 512 + tid, NGT = (G - 96) * 512;
        for (int i = gt; i < DEPTH * 16 * 31 * 256; i += NGT) { const int c = i & 15, cp = (i >> 4) & 15, ti = (i >> 8) % 31, lg = i / (256 * 31); const int tau = ti - 15;
            bf16_t* by = BTY + (size_t)lg * 256 * KY;
            if (tau < 0) { for (int t = 0; t <= 15 + tau; ++t) by[(size_t)(t * 16 + cp) * KY + (t - tau) * 16 + c] = 0; }
            else { const float* ap = APOW + ((size_t)lg * 17 + tau) * 128; const float* bp = BB + (size_t)lg * 64 * 32 + c * 2;
                const float* cr = INP(20) + ((size_t)lg * 16 + cp) * 64; const float* ci = INP(21) + ((size_t)lg * 16 + cp) * 64;
                float acc = 0.f;
                for (int p = 0; p < 64; ++p) { const float ar = ap[2 * p], ai = ap[2 * p + 1], br = bp[p * 32], bi = bp[p * 32 + 1];
                    const float wr_ = ar * br - ai * bi, wi_ = ar * bi + ai * br; acc += cr[p] * wr_ - ci[p] * wi_; }
                if (tau == 0 && c == cp) acc += INP(22)[lg * 16 + c];
                const bf16_t v = f2bf(acc);
                for (int t = tau; t < 16; ++t) by[(size_t)(t * 16 + cp) * KY + (t - tau) * 16 + c] = v; } }
        for (int i = gt; i < DEPTH * 16 * 16 * 16 * 64; i += NGT) { const int p = i & 63, cp = (i >> 6) & 15, t = (i >> 10) & 15, lg = i >> 14;
            const float ar = APOW[(((size_t)lg * 17 + t + 1) * 64 + p) * 2], ai = APOW[(((size_t)lg * 17 + t + 1) * 64 + p) * 2 + 1];
            const float cr = INP(20)[((size_t)lg * 16 + cp) * 64 + p], ci = INP(21)[((size_t)lg * 16 + cp) * 64 + p];
            bf16_t* by = BTY + ((size_t)lg * 256 + t * 16 + cp) * KY + 256; by[p] = f2bf(cr * ar - ci * ai); by[64 + p] = f2bf(-(cr * ai + ci * ar)); }
        for (int i = gt; i < DEPTH * 16 * 64 * 256; i += NGT) { const int c = i & 15, s = (i >> 4) & 15, p = (i >> 8) & 63, lg = i >> 14;
            const float ar = APOW[(((size_t)lg * 17 + 15 - s) * 64 + p) * 2], ai = APOW[(((size_t)lg * 17 + 15 - s) * 64 + p) * 2 + 1];
            const float br = BB[(((size_t)lg * 64 + p) * 16 + c) * 2], bi = BB[(((size_t)lg * 64 + p) * 16 + c) * 2 + 1];
            bf16_t* be = BTE + ((size_t)lg * 128 + p) * 256 + s * 16 + c; be[0] = f2bf(ar * br - ai * bi); be[(size_t)64 * 256] = f2bf(ar * bi + ai * br); }
        }
        __syncthreads();
        pg8::Gemm g{SC, WMOD, D, D, D, 0, (size_t)6144 * D * 2}; pg8::Order S; S.init(1, 24, DEPTH, G, bid, D / 64);
        EpiMod E{MOD, INP(12)};
        pg8::gemm_phase<EpiMod, true>(ldsl, g, S, E, wave);
    }
    PHASE_END

    PHASE_BEGIN
    norm_rows<false>(INP(0), INP(1), X, INP(9), MOD, MOD + 1024, XN, out, gw, NGW, lane, nullptr, 0);
    PHASE_END

#define MIX_TASK(task) do { if (task < 256) attn_prompt_unit(lds, Qb, Kb, Vb, MIX, sinks, task, tid); else if (task < 384) { __syncthreads(); attn_sample_wave((float*)(lds + wave * 4096), Qb, Kb, Vb, INP(4) + (size_t)l * NSB * 128 * 128, INP(5) + (size_t)l * NSB * 128 * 128, MIX, sinks, (task - 256) * 8 + wave, lane); } else if (task < 640) { __syncthreads(); ssm_sample_wave((float*)(lds + wave * 4096), ZUS, INP(6) + (size_t)l * NSB * 1024, INP(7) + (size_t)l * NSB * 1024, APOW + (size_t)l * 16 * 17 * 128, BB + (size_t)l * 16 * 64 * 32, INP(20) + (size_t)l * 16384, INP(21) + (size_t)l * 16384, INP(22) + l * 256, Zb, out + O_RS + (size_t)l * 131072, out + O_IS + (size_t)l * 131072, (task - 384) * 8 + wave, lane); } else if (task < 896) { const int tk = task - 640; _Pragma("unroll 1") for (int it = 0; it < 2; ++it) { const int tok = tk * 64 + (it * 8 + wave) * 4, t = tok & 4095; conv_group(VC, (size_t)tok, 30 - t, nullptr, INP(25) + (size_t)l * 31 * 256, INP(26) + l * 256, INP(27) + l * 256, INP(28) + l * 256, MIX, (size_t)tok, lane); } } else { const int b = (task - 896) * 8 + wave; conv_group(VC, (size_t)MP + b * 4, 0, INP(8) + ((size_t)l * NSB + b) * 30 * 256, INP(25) + (size_t)l * 31 * 256, INP(26) + l * 256, INP(27) + l * 256, INP(28) + l * 256, MIX, (size_t)MP + b * 4, lane); } } while (0)
#pragma unroll 1
    for (int l = 0; l < DEPTH; ++l) {
        PHASE_BEGIN
        {
            pg8::Gemm g{XN, WIN + (size_t)l * NIN * D, D, D, D, 0, 0}; pg8::Order S; S.init(M / 256, NIN / 256, 1, G, bid, D / 64);
            EpiIn E{Qb, Kb, Vb, ZUT, VC, ZUS, ROPE, out, l};
            pg8::gemm_phase<EpiIn, true>(ldsl, g, S, E, wave);
        }
        PHASE_END
        PHASE_BEGIN
        {
            const int NE = 64;
            if (bid < NE) {
                pg8::Gemm g{ZUT, BTE + (size_t)l * 16 * 128 * 256, 256, KY, 256, (size_t)NCHUNK * KY * 2, (size_t)128 * 256 * 2}; pg8::Order S; S.init(4, 1, 16, NE, bid, 4);
                EpiE E{ZUT, APOW + (size_t)l * 16 * 17 * 128, out + O_RP + (size_t)l * 4096, out + O_IP + (size_t)l * 4096};
                pg8::gemm_phase<EpiE, false>(ldsl, g, S, E, wave);
            }
            {
                const float* sinks = INP(14) + l * 8;
                for (int i = bid; i < 256; i += G) { const int task = i; MIX_TASK(task); }
                if (bid >= NE) for (int i = bid - NE; i < 256; i += G - NE) { const int task = 384 + i; MIX_TASK(task); }
                __syncthreads();
            }
        }
        PHASE_END
        PHASE_BEGIN
        {
            if (bid < 64) {
                pg8::Gemm g{ZUT, BTY + (size_t)l * 16 * 256 * KY, KY, KY, KY, (size_t)NCHUNK * KY * 2, (size_t)256 * KY * 2}; pg8::Order S; S.init(4, 1, 16, 64, bid, KY / 64);
                EpiY E{Zb};
                pg8::gemm_phase<EpiY, true>(ldsl, g, S, E, wave);
            } else {
                const float* sinks = INP(14) + l * 8;
                for (int i = bid - 64; i < 400; i += G - 64) { const int task = i < 128 ? 256 + i : 512 + i; MIX_TASK(task); }
                __syncthreads();
            }
        }
        PHASE_END
        PHASE_BEGIN
        {
            pg8::Gemm g{Zb, WGLU + (size_t)l * 65536, 256, 256, 256, 0, 0}; pg8::Order S; S.init(M / 256, 1, 1, G, bid, 4);
            EpiGlu E{Zb, MIX, INP(24) + l * 256};
            pg8::gemm_phase<EpiGlu, true>(ldsl, g, S, E, wave);
        }
        PHASE_END
        PHASE_BEGIN
        {
            pg8::Gemm g{MIX, WOUT + (size_t)l * D * D, D, D, D, 0, 0}; pg8::Order S; S.init_split(MP / 256, MS / 256, D / 256, G, bid, D / 64);
            EpiRes E{l == 0 ? INP(0) : nullptr, INP(1), X, (MOD + (size_t)l * NMODROWS * 6144) + 2048, (float*)(ws + WS_PART)};
            pg8::gemm_phase<EpiRes, true>(ldsl, g, S, E, wave);
        }
        PHASE_END
        PHASE_BEGIN
        norm_rows<false>(nullptr, nullptr, X, INP(10) + l * D, (MOD + (size_t)l * NMODROWS * 6144) + 3072, (MOD + (size_t)l * NMODROWS * 6144) + 4096, XN, nullptr, gw, NGW, lane, (const float*)(ws + WS_PART), D / 256);
        PHASE_END
        PHASE_BEGIN
        {
            pg8::Gemm g{XN, WGU + (size_t)l * NGU * D, D, D, D, 0, 0}; pg8::Order S; S.init(M / 256, NGU / 256, 1, G, bid, D / 64);
            EpiGU E{Hb};
            pg8::gemm_phase<EpiGU, true>(ldsl, g, S, E, wave);
        }
        PHASE_END
        PHASE_BEGIN
        {
            pg8::Gemm g{Hb, WDN + (size_t)l * D * DFF, DFF, DFF, DFF, 0, 0}; pg8::Order S; S.init_split(MP / 256, MS / 256, D / 256, G, bid, DFF / 64);
            EpiRes E{nullptr, nullptr, X, (MOD + (size_t)l * NMODROWS * 6144) + 5120, (float*)(ws + WS_PART)};
            pg8::gemm_phase<EpiRes, true>(ldsl, g, S, E, wave);
        }
        PHASE_END
        PHASE_BEGIN
        if (l + 1 < DEPTH) norm_rows<false>(nullptr, nullptr, X, INP(9) + (l + 1) * D, (MOD + (size_t)l * NMODROWS * 6144) + (size_t)NMODROWS * 6144, (MOD + (size_t)l * NMODROWS * 6144) + (size_t)NMODROWS * 6144 + 1024, XN, nullptr, gw, NGW, lane, (const float*)(ws + WS_PART), DFF / 256);
        else norm_rows<true>(nullptr, nullptr, X, INP(33), nullptr, nullptr, nullptr, out, gw, NGW, lane, (const float*)(ws + WS_PART), DFF / 256);
        PHASE_END
    }
}
constexpr int N_PHASES = 3 + 9 * DEPTH;
#ifndef PH_LIMIT
#define PH_LIMIT N_PHASES
#endif

extern "C" void kernel_launch(void* const* d_in, const int* in_sizes, int n_in, void* d_out, int out_size, void* d_ws, size_t ws_size, hipStream_t stream) {
    static int grid = 0;
    if (grid == 0) {
        if (n_in != 34 || (size_t)out_size != O_END || ws_size < WS_END) { fprintf(stderr, "kernel_launch: unexpected sizes n_in %d out %d ws %zu\n", n_in, out_size, ws_size); grid = -1; return; }
        int dev = 0, cus = 0, per_cu = 0;
        hipGetDevice(&dev); hipDeviceGetAttribute(&cus, hipDeviceAttributeMultiprocessorCount, dev);
        hipFuncSetAttribute((const void*)hybrid_fwd, hipFuncAttributeMaxDynamicSharedMemorySize, LDS_BYTES);
        hipOccupancyMaxActiveBlocksPerMultiprocessor(&per_cu, (const void*)hybrid_fwd, 512, LDS_BYTES);
        if (per_cu < 1) { fprintf(stderr, "kernel_launch: occupancy query says %d blocks per CU\n", per_cu); per_cu = 1; }
        grid = cus * per_cu; if (grid < 128) { fprintf(stderr, "kernel_launch: grid %d too small\n", grid); grid = -1; return; }
        fprintf(stderr, "kernel_launch: grid %d (cus %d x %d)\n", grid, cus, per_cu);
    }
    if (grid < 0) return;
    if (hipMemsetAsync(d_ws, 0, XCD_BAR_WORDS * 4, stream) != hipSuccess) { fprintf(stderr, "kernel_launch: memset failed\n"); return; }
    Params p{};
    for (int i = 0; i < 34; ++i) p.in[i] = (const float*)d_in[i];
    p.out = (float*)d_out; p.ws = (unsigned char*)d_ws;
#if MK_LAUNCH_PER_PHASE
    for (int ph = 0; ph < PH_LIMIT; ++ph) { p.ph_lo = ph; p.ph_hi = ph + 1; hipLaunchKernelGGL(hybrid_fwd, dim3(grid), dim3(512), LDS_BYTES, stream, p); }
#else
    p.ph_lo = 0; p.ph_hi = N_PHASES;
    void* args[] = {&p};
    hipError_t e = hipLaunchCooperativeKernel((const void*)hybrid_fwd, dim3(grid), dim3(512), args, LDS_BYTES, stream);
    if (e != hipSuccess) fprintf(stderr, "cooperative launch failed: %s (grid %d)\n", hipGetErrorString(e), grid);
#endif
}
```

```cpp
#include <hip/hip_runtime.h>
#include <hip/hip_cooperative_groups.h>
#include <cstdio>
#include <cstdint>
namespace cg = cooperative_groups;


#ifndef MK_LAUNCH_PER_PHASE
#define MK_LAUNCH_PER_PHASE 0
#endif

#define LAS __attribute__((address_space(3)))
typedef unsigned short bf16_t;
typedef short bf16x8 __attribute__((ext_vector_type(8)));
typedef float f32x4 __attribute__((ext_vector_type(4)));
typedef float f32x16 __attribute__((ext_vector_type(16)));
typedef unsigned u32x4 __attribute__((ext_vector_type(4)));
typedef unsigned u32x2 __attribute__((ext_vector_type(2)));

constexpr int D = 1024, NPB = 4, SEQ = 4096, DEPTH = 4, NSB = 128, SSEQ = 4;
constexpr int MP = NPB * SEQ;
constexpr int MS = NSB * SSEQ;
constexpr int M = MP + MS;
constexpr int NIN = 1536, DFF = 2816, NGU = 2 * DFF;
constexpr int NMODROWS = NPB + NSB;
constexpr int CT = 16;
constexpr int NCHUNK = MP / CT;
constexpr int KY = 384;
constexpr float EPS = 1e-6f;

constexpr size_t MiB = 1u << 20;
constexpr size_t WS_ROPE = 1 * MiB, WS_SC = 3 * MiB, WS_APOW = 4 * MiB, WS_BB = 5 * MiB, WS_MOD = 8 * MiB;
constexpr size_t WS_WGLU = 22 * MiB, WS_BTE = 23 * MiB, WS_BTY = 28 * MiB, WS_WIN = 40 * MiB, WS_WOUT = 52 * MiB;
constexpr size_t WS_WGU = 60 * MiB, WS_WDN = 104 * MiB, WS_X = 126 * MiB, WS_XN = 192 * MiB, WS_H = 225 * MiB;
constexpr size_t WS_MIX = 225 * MiB, WS_Q = 258 * MiB, WS_K = 275 * MiB, WS_V = 280 * MiB, WS_ZUT = 285 * MiB;
constexpr size_t WS_VC = 297 * MiB, WS_Z = 306 * MiB, WS_ZUS = 315 * MiB, WS_WMOD = 225 * MiB, WS_PART = 316 * MiB, WS_END = 362 * MiB;

constexpr size_t O_YP = 0, O_YS = O_YP + (size_t)MP * D, O_KP = O_YS + (size_t)MS * D, O_VP = O_KP + 262144, O_RP = O_VP + 262144;
constexpr size_t O_IP = O_RP + 16384, O_CP = O_IP + 16384, O_KS = O_CP + 122880, O_VS = O_KS + 8388608, O_RS = O_VS + 8388608;
constexpr size_t O_IS = O_RS + 524288, O_CS = O_IS + 524288, O_END = O_CS + 3932160;

constexpr int LDS_BYTES = 147456;

typedef float f32x2_t __attribute__((ext_vector_type(2))); typedef __bf16 bf16x2_t __attribute__((ext_vector_type(2)));
__device__ __forceinline__ unsigned cvt_pk_bf16(float lo, float hi) { const f32x2_t v = {lo, hi}; const bf16x2_t b = __builtin_convertvector(v, bf16x2_t); return __builtin_bit_cast(unsigned, b); }
__device__ __forceinline__ float bf2f(unsigned h) { return __builtin_bit_cast(float, h << 16); }
__device__ __forceinline__ float bflo(unsigned w) { return __builtin_bit_cast(float, w << 16); }
__device__ __forceinline__ float bfhi(unsigned w) { return __builtin_bit_cast(float, w & 0xffff0000u); }
__device__ __forceinline__ bf16_t f2bf(float f) { return (bf16_t)(cvt_pk_bf16(f, 0.f) & 0xffffu); }
__device__ __forceinline__ float sigmoidf_(float x) { return __builtin_amdgcn_rcpf(1.0f + __expf(-x)); }
__device__ __forceinline__ float gelu_tanh(float y) { const float u = 0.7978845608028654f * (y + 0.044715f * y * y * y); return y * (1.0f - __builtin_amdgcn_rcpf(1.0f + __expf(2.0f * u))); }
__device__ __forceinline__ void cis_rev(double ang, float& c, float& s) { double rev = ang * 0.15915494309189535; rev -= rint(rev); const float x = (float)(rev * 6.283185307179586); s = sinf(x); c = cosf(x); }
__device__ __forceinline__ float swz_f(float v, int pat) { return 0.f; }
#define SWZ(v, pat) __builtin_bit_cast(float, __builtin_amdgcn_ds_swizzle(__builtin_bit_cast(int, (v)), (pat)))
__device__ __forceinline__ float xor32_sum(float v) { float a = v, b = v; asm volatile("s_nop 1\n\tv_permlane32_swap_b32 %0, %1\n\ts_nop 1" : "+v"(a), "+v"(b)); return a + b; }
__device__ __forceinline__ float xor32_max(float v) { float a = v, b = v; asm volatile("s_nop 1\n\tv_permlane32_swap_b32 %0, %1\n\ts_nop 1" : "+v"(a), "+v"(b)); return fmaxf(a, b); }
__device__ __forceinline__ float wave_sum(float v) {
    v += SWZ(v, 0x041f); v += SWZ(v, 0x081f); v += SWZ(v, 0x101f); v += SWZ(v, 0x201f); v += SWZ(v, 0x401f); return xor32_sum(v);
}
__device__ __forceinline__ float wave_max(float v) {
    v = fmaxf(v, SWZ(v, 0x041f)); v = fmaxf(v, SWZ(v, 0x081f)); v = fmaxf(v, SWZ(v, 0x101f)); v = fmaxf(v, SWZ(v, 0x201f)); v = fmaxf(v, SWZ(v, 0x401f)); return xor32_max(v);
}

namespace pg8 {
constexpr int BM = 256, BK = 64, HALF = 128, HTB = HALF * BK * 2, STAGE_BYTES = 8 * HTB, NXCD = 8, WGM = 8;
__host__ __device__ __forceinline__ int lds_byte(int r, int c) { const int st = (r >> 4) * 2 + (c >> 5), rr = r & 15, cc = c & 31, ob = rr * 64 + cc * 2; return st * 1024 + (ob ^ (((ob >> 9) & 1) << 5)); }
__host__ __device__ __forceinline__ void stage_rc(int b, int& R, int& C) { const int st = b / 1024, sb = b % 1024, swz = sb ^ (((sb >> 9) & 1) << 5); R = (st >> 1) * 16 + swz / 64; C = (st & 1) * 32 + (swz % 64) / 2; }

__host__ __device__ __forceinline__ int perm32(int rho) { const int n = rho >> 4, i = rho & 15; return 8 * (i >> 2) + 4 * n + (i & 3); }
struct Unit { int pm, pn, z, k0, nt, split; };
struct Gemm { const bf16_t* A; const bf16_t* Bt; int K, lda, ldb; size_t sAz, sBz; };

struct Order {
    int nM, nN, nwg, tot, G, c, ntK, nsplit, nMfull;
    __device__ void init(int nM_, int nN_, int nZ_, int G_, int c_, int ntK_) { nM = nM_; nN = nN_; nwg = nM_ * nN_; tot = nwg * nZ_; G = G_; c = c_; ntK = ntK_; nsplit = 0; nMfull = nM_; }
    __device__ void init_split(int nMfull_, int nMtail, int nN_, int G_, int c_, int ntK_) { nM = nMfull_; nN = nN_; nwg = nMfull_ * nN_; nsplit = ntK_ / 4; tot = nwg + nMtail * nN_ * nsplit; G = G_; c = c_; ntK = ntK_; nMfull = nMfull_; }
    __device__ bool next(int i, Unit& u) const {
        const long L = (long)i * G + c; if (c < 0 || L >= tot) return false;
        if (nsplit > 0 && L >= nwg) { const int r = (int)L - nwg, su = r / nsplit, sp = r % nsplit; u.pm = nMfull + su / nN; u.pn = su % nN; u.z = 0; u.k0 = sp * 256; u.nt = 4; u.split = 1; return true; }
        const int z = (int)(L / nwg); int wgid = (int)(L % nwg);
        { const int q = nwg / NXCD, r = nwg % NXCD, xcd = wgid % NXCD, off = wgid / NXCD; wgid = (xcd < r ? xcd * (q + 1) : r * (q + 1) + (xcd - r) * q) + off; }
        const int nig = WGM * nN, gid = wgid / nig, fm = gid * WGM, gsz = (nM - fm) < WGM ? (nM - fm) : WGM;
        u.pm = fm + ((wgid % nig) % gsz); u.pn = (wgid % nig) / gsz; u.z = z; u.k0 = 0; u.nt = ntK; u.split = 0; return true;
    }
};

template <class Epi, bool ALIGN_EPI>
__device__ __forceinline__ void gemm_phase(LAS unsigned char* lds, const Gemm g, const Order& S, const Epi& E, const int wave_id) {
    int lane; asm volatile("v_mbcnt_lo_u32_b32 %0, -1, 0\n\tv_mbcnt_hi_u32_b32 %0, -1, %0" : "=v"(lane));
    int wid = wave_id; asm volatile("" : "+s"(wid)); const int tid = wid * 64 + lane, wr = wid >> 2, wc = wid & 3, fr = lane & 15, fq = lane >> 4;
    unsigned voffA[2], voffB[2];
#pragma unroll
    for (int i = 0; i < 2; ++i) { int R, C; stage_rc(tid * 16 + i * 8192, R, C); const int Rb = Epi::PERM ? ((R & ~31) + perm32(R & 31)) : R; voffA[i] = (unsigned)(R * g.lda + C) * 2u; voffB[i] = (unsigned)(Rb * g.ldb + C) * 2u; }
    const size_t kstep = (size_t)(BK * 2);
    const size_t hstepA = (size_t)HALF * g.lda * 2, hstepB = (size_t)HALF * g.ldb * 2;
    const unsigned ldsw = (unsigned)wid * 1024u;
    const int aoff = lds_byte(wr * 64 + fr, fq * 8), boff = lds_byte(wc * 32 + fr, fq * 8);
#define PG8_SA(b, h) (((b) * 2 + (h)) * HTB)
#define PG8_SB(b, h) ((4 + (b) * 2 + (h)) * HTB)
#define PG8_STAGE(bufoff, gbase, voff) do { _Pragma("unroll") for (int _i = 0; _i < 2; ++_i) \
        __builtin_amdgcn_global_load_lds((const unsigned*)((const char*)(gbase) + (voff)[_i]), (LAS unsigned*)(lds + (bufoff) + ldsw + _i * 8192), 16, 0, 0); } while (0)
#define PG8_LDA(dst, b, h) do { _Pragma("unroll") for (int m = 0; m < 4; ++m) _Pragma("unroll") for (int k = 0; k < 2; ++k) dst[m][k] = *(const LAS bf16x8*)(lds + PG8_SA(b, h) + aoff + m * 2048 + k * 1024); } while (0)
#define PG8_LDB(dst, b, h) do { _Pragma("unroll") for (int n = 0; n < 2; ++n) _Pragma("unroll") for (int k = 0; k < 2; ++k) dst[n][k] = *(const LAS bf16x8*)(lds + PG8_SB(b, h) + boff + n * 2048 + k * 1024); } while (0)
#define PG8_MMA(ai, bj, At, Bt) do { __builtin_amdgcn_s_setprio(1); _Pragma("unroll") for (int m = 0; m < 4; ++m) _Pragma("unroll") for (int n = 0; n < 2; ++n) _Pragma("unroll") for (int k = 0; k < 2; ++k) \
        acc[ai][bj][m][n] = __builtin_amdgcn_mfma_f32_16x16x32_bf16(Bt[n][k], At[m][k], acc[ai][bj][m][n], 0, 0, 0); __builtin_amdgcn_s_setprio(0); } while (0)
#define PG8_WAIT_V(n) asm volatile("s_waitcnt vmcnt(" #n ")" ::: "memory")
#define PG8_WAIT_L(n) asm volatile("s_waitcnt lgkmcnt(" #n ")" ::: "memory")
#define PG8_BAR __builtin_amdgcn_s_barrier()
#define PG8_SCHED __builtin_amdgcn_sched_barrier(0)
    Unit cur, nxt; int ui = 0;
    if (!S.next(0, cur)) return;
    f32x4 acc[2][2][4][2];
#pragma unroll
    for (int a = 0; a < 2; ++a)
#pragma unroll
        for (int b = 0; b < 2; ++b)
#pragma unroll
            for (int m = 0; m < 4; ++m)
#pragma unroll
                for (int n = 0; n < 2; ++n) acc[a][b][m][n] = (f32x4){0.f, 0.f, 0.f, 0.f};
    bf16x8 At[4][2], B0[2][2], B1[2][2];
    const char* cA = (const char*)g.A + (size_t)cur.z * g.sAz + (size_t)cur.pm * 2 * hstepA + (size_t)cur.k0 * 2; const char* cB = (const char*)g.Bt + (size_t)cur.z * g.sBz + (size_t)cur.pn * 2 * hstepB + (size_t)cur.k0 * 2;
    PG8_STAGE(PG8_SB(0, 0), cB, voffB); PG8_STAGE(PG8_SB(0, 1), cB + hstepB, voffB); PG8_STAGE(PG8_SA(0, 0), cA, voffA); PG8_STAGE(PG8_SA(0, 1), cA + hstepA, voffA);
    if (wr == 1) PG8_BAR;
    PG8_WAIT_V(2); PG8_BAR;
    PG8_STAGE(PG8_SB(1, 0), cB + kstep, voffB); PG8_STAGE(PG8_SA(1, 0), cA + kstep, voffA); PG8_STAGE(PG8_SB(1, 1), cB + hstepB + kstep, voffB);
    PG8_WAIT_V(6); PG8_BAR;
    for (;;) {
        const bool has_next = S.next(ui + 1, nxt);
        const char* nA = has_next ? (const char*)g.A + (size_t)nxt.z * g.sAz + (size_t)nxt.pm * 2 * hstepA + (size_t)nxt.k0 * 2 : cA;
        const char* nB = has_next ? (const char*)g.Bt + (size_t)nxt.z * g.sBz + (size_t)nxt.pn * 2 * hstepB + (size_t)nxt.k0 * 2 : cB;
        const int nt = cur.nt;
        for (int t = 0; t < nt; t += 2) {
            const bool last = (t == nt - 2);
            const char* a1 = cA + (size_t)(t + 1) * kstep;
            const char* a2 = last ? nA : cA + (size_t)(t + 2) * kstep; const char* b2 = last ? nB : cB + (size_t)(t + 2) * kstep;
            const char* a3 = a2 + kstep; const char* b3 = b2 + kstep;
            PG8_LDB(B0, 0, 0); PG8_LDB(B1, 0, 1); PG8_SCHED; PG8_LDA(At, 0, 0); PG8_STAGE(PG8_SA(1, 1), a1 + hstepA, voffA);
            PG8_WAIT_V(8); PG8_WAIT_L(0); PG8_BAR; PG8_MMA(0, 0, At, B0); PG8_MMA(0, 1, At, B1); PG8_BAR; PG8_SCHED;
            PG8_LDA(At, 0, 1); PG8_STAGE(PG8_SB(0, 0), b2, voffB); PG8_STAGE(PG8_SB(0, 1), b2 + hstepB, voffB); PG8_STAGE(PG8_SA(0, 0), a2, voffA);
            PG8_WAIT_V(8); PG8_WAIT_L(0); PG8_BAR; PG8_MMA(1, 0, At, B0); PG8_MMA(1, 1, At, B1); PG8_BAR; PG8_SCHED;
            PG8_LDB(B0, 1, 0); PG8_LDB(B1, 1, 1); PG8_SCHED; PG8_LDA(At, 1, 0); PG8_STAGE(PG8_SA(0, 1), a2 + hstepA, voffA);
            PG8_WAIT_V(8); PG8_WAIT_L(0); PG8_BAR; PG8_MMA(0, 0, At, B0); PG8_MMA(0, 1, At, B1); PG8_BAR; PG8_SCHED;
            PG8_LDA(At, 1, 1); PG8_STAGE(PG8_SB(1, 0), b3, voffB); PG8_STAGE(PG8_SB(1, 1), b3 + hstepB, voffB); PG8_STAGE(PG8_SA(1, 0), a3, voffA);
            PG8_WAIT_V(8); PG8_WAIT_L(0); PG8_BAR; PG8_MMA(1, 0, At, B0); PG8_MMA(1, 1, At, B1); PG8_BAR; PG8_SCHED;
        }
        if constexpr (ALIGN_EPI) { if (wr == 0) PG8_BAR; }
        if constexpr (!Epi::AFTER_DRAIN) { int fr_e = fr, fq_e = fq; asm volatile("" : "+v"(fr_e), "+v"(fq_e)); E(acc, cur, wr, wc, fr_e, fq_e); }
        if (!has_next) break;
#pragma unroll
        for (int a = 0; a < 2; ++a)
#pragma unroll
            for (int b = 0; b < 2; ++b)
#pragma unroll
                for (int m = 0; m < 4; ++m)
#pragma unroll
                    for (int n = 0; n < 2; ++n) acc[a][b][m][n] = (f32x4){0.f, 0.f, 0.f, 0.f};
        cur = nxt; cA = nA; cB = nB; ++ui;
        if constexpr (ALIGN_EPI) { if (wr == 1) PG8_BAR; }
    }
    PG8_WAIT_V(0);
    if constexpr (!ALIGN_EPI) { if (wr == 0) PG8_BAR; }
    PG8_BAR;
    if constexpr (Epi::AFTER_DRAIN) { E.fused(acc, cur, wr, wc, fr, fq, lds, wid, lane); }
#undef PG8_SA
#undef PG8_SB
#undef PG8_STAGE
#undef PG8_LDA
#undef PG8_LDB
#undef PG8_MMA
#undef PG8_WAIT_V
#undef PG8_WAIT_L
#undef PG8_BAR
#undef PG8_SCHED
}
}
using pg8::Unit;
typedef f32x4 Acc[2][2][4][2];

__device__ __forceinline__ int mod_row(int row) { return row < MP ? (row >> 12) : NPB + ((row - MP) >> 2); }

struct EpiMod {
    static constexpr bool AFTER_DRAIN = false, PERM = false;
    float* mod; const float* bmod;
    __device__ __forceinline__ void operator()(const Acc& acc, const Unit& u, int wr, int wc, int fr, int fq) const {
#pragma unroll
        for (int ai = 0; ai < 2; ++ai)
#pragma unroll
            for (int m = 0; m < 4; ++m) { const int row = ai * 128 + wr * 64 + m * 16 + fr;
                if (row < NMODROWS) {
#pragma unroll
                    for (int bj = 0; bj < 2; ++bj)
#pragma unroll
                        for (int n = 0; n < 2; ++n) { const int col = u.pn * 256 + bj * 128 + wc * 32 + n * 16 + fq * 4;
                            const f32x4 b = *(const f32x4*)(bmod + (size_t)u.z * 6144 + col);
                            *(f32x4*)(mod + ((size_t)u.z * NMODROWS + row) * 6144 + col) = acc[ai][bj][m][n] + b; } } }
    }
};

struct EpiIn {
    static constexpr bool AFTER_DRAIN = false, PERM = false;
    bf16_t *Q, *Kb, *Vb, *ZUT, *VC; float* ZUS; const float* rope;
    float* out; int l;
    __device__ __forceinline__ void operator()(const Acc& acc, const Unit& u, int wr, int wc, int fr, int fq) const {
#pragma unroll
        for (int ai = 0; ai < 2; ++ai)
#pragma unroll
            for (int m = 0; m < 4; ++m) {
                const int row = u.pm * 256 + ai * 128 + wr * 64 + m * 16 + fr;
                const bool samp = row >= MP; const int rs = row - MP;
                const int b = samp ? (rs >> 2) : (row >> 12), t = samp ? (rs & 3) : (row & 4095);
                const float* rp = rope + (size_t)(samp ? 4096 + t : t) * 64;
                if (u.pn <= 1) {
#pragma unroll
                    for (int n = 0; n < 2; ++n) { const int d = n * 16 + fq * 4;
                        const f32x4 cs = *(const f32x4*)(rp + d), sn = *(const f32x4*)(rp + 32 + d);
                        const f32x4 x1 = acc[ai][0][m][n], x2 = acc[ai][1][m][n];
                        const f32x4 o1 = (x1 * cs - x2 * sn) * 0.125f, o2 = (x2 * cs + x1 * sn) * 0.125f;
                        bf16_t* qp = Q + (size_t)row * 512 + (u.pn * 4 + wc) * 64 + d;
                        *(u32x2*)qp = (u32x2){cvt_pk_bf16(o1[0], o1[1]), cvt_pk_bf16(o1[2], o1[3])};
                        *(u32x2*)(qp + 32) = (u32x2){cvt_pk_bf16(o2[0], o2[1]), cvt_pk_bf16(o2[2], o2[3])}; }
                } else if (u.pn == 2) {
                    const bool keep = samp || t >= SEQ - 128;
                    const size_t orow = samp ? ((size_t)b * 128 + 124 + t) : ((size_t)b * 128 + (t - (SEQ - 128)));
                    const size_t okoff = samp ? (O_KS + (size_t)l * 2097152) : (O_KP + (size_t)l * 65536), ovoff = samp ? (O_VS + (size_t)l * 2097152) : (O_VP + (size_t)l * 65536);
                    if (wc < 2) {
#pragma unroll
                        for (int n = 0; n < 2; ++n) { const int d = n * 16 + fq * 4;
                            const f32x4 cs = *(const f32x4*)(rp + d), sn = *(const f32x4*)(rp + 32 + d);
                            const f32x4 x1 = acc[ai][0][m][n], x2 = acc[ai][1][m][n];
                            const f32x4 o1 = x1 * cs - x2 * sn, o2 = x2 * cs + x1 * sn;
                            bf16_t* kp = Kb + (size_t)row * 128 + wc * 64 + d;
                            *(u32x2*)kp = (u32x2){cvt_pk_bf16(o1[0], o1[1]), cvt_pk_bf16(o1[2], o1[3])};
                            *(u32x2*)(kp + 32) = (u32x2){cvt_pk_bf16(o2[0], o2[1]), cvt_pk_bf16(o2[2], o2[3])};
                            if (keep) { float* op = out + okoff + (orow * 2 + wc) * 64 + d; *(f32x4*)op = o1; *(f32x4*)(op + 32) = o2; } }
                    } else {
#pragma unroll
                        for (int bj = 0; bj < 2; ++bj)
#pragma unroll
                            for (int n = 0; n < 2; ++n) { const int d = (wc - 2) * 32 + n * 16 + fq * 4; const f32x4 v = acc[ai][bj][m][n];
                                *(u32x2*)(Vb + (size_t)row * 128 + bj * 64 + d) = (u32x2){cvt_pk_bf16(v[0], v[1]), cvt_pk_bf16(v[2], v[3])};
                                if (keep) *(f32x4*)(out + ovoff + (orow * 2 + bj) * 64 + d) = v; }
                    }
                } else if (u.pn == 3) {
#pragma unroll
                    for (int bj = 0; bj < 2; ++bj)
#pragma unroll
                        for (int n = 0; n < 2; ++n) { const int col = bj * 128 + wc * 32 + n * 16 + fq * 4; const f32x4 v = acc[ai][bj][m][n];
                            if (samp) *(f32x4*)(ZUS + (size_t)rs * 256 + col) = v;
                            else *(u32x2*)(ZUT + ((size_t)(col >> 4) * NCHUNK + (row >> 4)) * KY + (row & 15) * 16 + (col & 15)) = (u32x2){cvt_pk_bf16(v[0], v[1]), cvt_pk_bf16(v[2], v[3])}; }
                } else {
                    const bool keep = samp || t >= SEQ - 30;
                    const size_t orow = samp ? ((size_t)b * 30 + 26 + t) : ((size_t)b * 30 + (t - (SEQ - 30)));
                    const size_t ocoff = samp ? (O_CS + (size_t)l * 983040) : (O_CP + (size_t)l * 30720);
#pragma unroll
                    for (int n = 0; n < 2; ++n) { const int ch = (u.pn - 4) * 128 + wc * 32 + n * 16 + fq * 4;
                        const f32x4 za = acc[ai][0][m][n], zg = acc[ai][1][m][n]; f32x4 v;
#pragma unroll
                        for (int i = 0; i < 4; ++i) v[i] = za[i] * sigmoidf_(zg[i]);
                        *(u32x2*)(VC + (size_t)row * 256 + ch) = (u32x2){cvt_pk_bf16(v[0], v[1]), cvt_pk_bf16(v[2], v[3])};
                        if (keep) *(f32x4*)(out + ocoff + orow * 256 + ch) = v; }
                }
            }
    }
};

struct EpiE {
    static constexpr bool AFTER_DRAIN = true, PERM = false;
    bf16_t* ZUT; const float* apow;
    float *ore, *oim;
    __device__ __forceinline__ void fused(const Acc& acc, const Unit& u, int wr, int wc, int fr, int fq, LAS unsigned char* lds, int wid, int lane) const {
        LAS float* Es = (LAS float*)lds;
#pragma unroll
        for (int ai = 0; ai < 2; ++ai)
#pragma unroll
            for (int m = 0; m < 4; ++m)
#pragma unroll
                for (int n = 0; n < 2; ++n) { const int r = ai * 128 + wr * 64 + m * 16 + fr, c = wc * 32 + n * 16 + fq * 4; *(LAS f32x4*)(Es + r * 128 + c) = acc[ai][0][m][n]; }
        __syncthreads();
        if (wid == 0) {
            const int g = u.z, b = u.pm, p = lane;
            const float ar = apow[((g * 17 + 16) * 64 + p) * 2], aim = apow[((g * 17 + 16) * 64 + p) * 2 + 1];
            float hr = 0.f, hi = 0.f;
            bf16_t* zp = ZUT + ((size_t)g * NCHUNK + (size_t)b * 256) * KY + 256 + p;
            float er = Es[p], ei = Es[64 + p];
            for (int j = 0; j < 256; ++j) {
                zp[(size_t)j * KY] = f2bf(hr); zp[(size_t)j * KY + 64] = f2bf(hi);
                const int jn = j < 255 ? j + 1 : 255; const float ern = Es[jn * 128 + p], ein = Es[jn * 128 + 64 + p];
                const float nr = ar * hr - aim * hi + er, ni = ar * hi + aim * hr + ei; hr = nr; hi = ni; er = ern; ei = ein;
            }
            ore[(b * 16 + g) * 64 + p] = hr; oim[(b * 16 + g) * 64 + p] = hi;
        }
        __syncthreads();
    }
};

struct EpiY {
    static constexpr bool AFTER_DRAIN = false, PERM = false;
    bf16_t* Z;
    __device__ __forceinline__ void operator()(const Acc& acc, const Unit& u, int wr, int wc, int fr, int fq) const {
#pragma unroll
        for (int ai = 0; ai < 2; ++ai)
#pragma unroll
            for (int m = 0; m < 4; ++m) { const int crow = u.pm * 256 + ai * 128 + wr * 64 + m * 16 + fr;
#pragma unroll
                for (int bj = 0; bj < 2; ++bj)
#pragma unroll
                    for (int n = 0; n < 2; ++n) { const int col = bj * 128 + wc * 32 + n * 16 + fq * 4, t = col >> 4, cp = col & 15; const f32x4 v = acc[ai][bj][m][n];
                        *(u32x2*)(Z + ((size_t)crow * 16 + t) * 256 + u.z * 16 + cp) = (u32x2){cvt_pk_bf16(gelu_tanh(v[0]), gelu_tanh(v[1])), cvt_pk_bf16(gelu_tanh(v[2]), gelu_tanh(v[3]))}; } }
    }
};

struct EpiGlu {
    static constexpr bool AFTER_DRAIN = false, PERM = false;
    const bf16_t* Z; bf16_t* MIX; const float* bglu;
    __device__ __forceinline__ void operator()(const Acc& acc, const Unit& u, int wr, int wc, int fr, int fq) const {
#pragma unroll
        for (int ai = 0; ai < 2; ++ai)
#pragma unroll
            for (int m = 0; m < 4; ++m) { const int row = u.pm * 256 + ai * 128 + wr * 64 + m * 16 + fr;
#pragma unroll
                for (int bj = 0; bj < 2; ++bj)
#pragma unroll
                    for (int n = 0; n < 2; ++n) { const int col = bj * 128 + wc * 32 + n * 16 + fq * 4; const f32x4 a = acc[ai][bj][m][n] + *(const f32x4*)(bglu + col);
                        const u32x2 zw = *(const u32x2*)(Z + (size_t)row * 256 + col);
                        const float o0 = bflo(zw.x) * sigmoidf_(a[0]), o1 = bfhi(zw.x) * sigmoidf_(a[1]), o2 = bflo(zw.y) * sigmoidf_(a[2]), o3 = bfhi(zw.y) * sigmoidf_(a[3]);
                        *(u32x2*)(MIX + (size_t)row * 1024 + 512 + col) = (u32x2){cvt_pk_bf16(o0, o1), cvt_pk_bf16(o2, o3)}; } }
    }
};

struct EpiRes {
    static constexpr bool AFTER_DRAIN = false, PERM = false;
    const float *xp, *xs;
    float* X; const float* gate; float* part;
    __device__ __forceinline__ void operator()(const Acc& acc, const Unit& u, int wr, int wc, int fr, int fq) const {
#pragma unroll
        for (int ai = 0; ai < 2; ++ai)
#pragma unroll
            for (int m = 0; m < 4; ++m) { const int row = u.pm * 256 + ai * 128 + wr * 64 + m * 16 + fr;
                const float* base = xp ? (row < MP ? xp + (size_t)row * D : xs + (size_t)(row - MP) * D) : X + (size_t)row * D;
                const float* gp = gate + (size_t)mod_row(row) * 6144;
#pragma unroll
                for (int bj = 0; bj < 2; ++bj)
#pragma unroll
                    for (int n = 0; n < 2; ++n) { const int col = u.pn * 256 + bj * 128 + wc * 32 + n * 16 + fq * 4;
                        const f32x4 ga = *(const f32x4*)(gp + col) * acc[ai][bj][m][n];
                        if (u.split) { *(f32x4*)(part + ((size_t)(u.k0 >> 8) * MS + (row - MP)) * D + col) = ga;
                        } else *(f32x4*)(X + (size_t)row * D + col) = *(const f32x4*)(base + col) + ga; } }
    }
};

struct EpiGU {
    static constexpr bool AFTER_DRAIN = false, PERM = true;
    bf16_t* H;
    __device__ __forceinline__ void operator()(const Acc& acc, const Unit& u, int wr, int wc, int fr, int fq) const {
#pragma unroll
        for (int ai = 0; ai < 2; ++ai)
#pragma unroll
            for (int m = 0; m < 4; ++m) { const int row = u.pm * 256 + ai * 128 + wr * 64 + m * 16 + fr;
                const int col = u.pn * 128 + wc * 32 + fq * 8; u32x4 w;
#pragma unroll
                for (int n = 0; n < 2; ++n) { const f32x4 g = acc[ai][0][m][n], up = acc[ai][1][m][n]; f32x4 h;
#pragma unroll
                    for (int i = 0; i < 4; ++i) h[i] = g[i] * sigmoidf_(g[i]) * up[i];
                    w[2 * n] = cvt_pk_bf16(h[0], h[1]); w[2 * n + 1] = cvt_pk_bf16(h[2], h[3]); }
                *(u32x4*)(H + (size_t)row * DFF + col) = w; }
    }
};

struct Params { const float* in[34]; float* out; unsigned char* ws; int ph_lo, ph_hi; };

__device__ __forceinline__ void transpose_item(const float* W, int K, int N, bf16_t* WT, int n0, int k0, int drow0, float* scr, int lane) {
    float wreg[32];
#pragma unroll
    for (int i = 0; i < 32; ++i) wreg[i] = W[(size_t)(k0 + 2 * i + (lane >> 5)) * N + n0 + (lane & 31)];
#pragma unroll
    for (int i = 0; i < 32; ++i) { const int kk = 2 * i + (lane >> 5); scr[kk * 33 + (lane & 31)] = wreg[i]; }
    asm volatile("s_waitcnt lgkmcnt(0)" ::: "memory");
    const int c = lane & 7;
#pragma unroll
    for (int j = 0; j < 4; ++j) { const int n = (lane >> 3) + 8 * j; const float* s = scr + (8 * c) * 33 + n;
        u32x4 o; o.x = cvt_pk_bf16(s[0 * 33], s[1 * 33]); o.y = cvt_pk_bf16(s[2 * 33], s[3 * 33]); o.z = cvt_pk_bf16(s[4 * 33], s[5 * 33]); o.w = cvt_pk_bf16(s[6 * 33], s[7 * 33]);
        *(u32x4*)(WT + (size_t)(drow0 + n) * K + k0 + 8 * c) = o; }
    asm volatile("s_waitcnt lgkmcnt(0)" ::: "memory");
}
__device__ __forceinline__ int win_dst_row(int c) {
    if (c < 512) { const int tile = c >> 8, cc = c & 255; return tile * 256 + 128 * ((cc & 63) >> 5) + 32 * (cc >> 6) + (cc & 31); }
    if (c < 640) { const int cc = c - 512; return 512 + 128 * ((cc & 63) >> 5) + 32 * (cc >> 6) + (cc & 31); }
    if (c < 768) { const int cc = c - 640; return 512 + 128 * (cc >> 6) + 64 + (cc & 63); }
    if (c < 1024) return c;
    if (c < 1280) { const int cc = c - 1024; return 1024 + 256 * (cc >> 7) + (cc & 127); }
    { const int cc = c - 1280; return 1024 + 256 * (cc >> 7) + 128 + (cc & 127); }
}

template <bool FINAL>
__device__ __forceinline__ void norm_rows(const float* xp, const float* xs, const float* X, const float* g, const float* sh, const float* sc, bf16_t* XN, float* out, int gw, int NGW, int lane, const float* part, int nsplit) {
    f32x4 vnext[4];
    if (gw < M) { const float* xr0 = xp ? (gw < MP ? xp + (size_t)gw * D : xs + (size_t)(gw - MP) * D) : X + (size_t)gw * D;
#pragma unroll
        for (int j = 0; j < 4; ++j) vnext[j] = *(const f32x4*)(xr0 + 4 * lane + 256 * j); }
    for (int row = gw; row < M; row += NGW) {
        f32x4 v[4]; float s = 0.f;
#pragma unroll
        for (int j = 0; j < 4; ++j) v[j] = vnext[j];
        { const int rn = row + NGW; if (rn < M) { const float* xrn = xp ? (rn < MP ? xp + (size_t)rn * D : xs + (size_t)(rn - MP) * D) : X + (size_t)rn * D;
#pragma unroll
            for (int j = 0; j < 4; ++j) vnext[j] = *(const f32x4*)(xrn + 4 * lane + 256 * j); } }
        if (nsplit > 0 && row >= MP) {
            for (int sp = 0; sp < nsplit; ++sp) { const float* pr = part + ((size_t)sp * MS + (row - MP)) * D + 4 * lane;
#pragma unroll
                for (int j = 0; j < 4; ++j) v[j] += *(const f32x4*)(pr + 256 * j); }
#pragma unroll
            for (int j = 0; j < 4; ++j) *(f32x4*)((float*)X + (size_t)row * D + 4 * lane + 256 * j) = v[j]; }
#pragma unroll
        for (int j = 0; j < 4; ++j) s += (v[j][0] * v[j][0] + v[j][1] * v[j][1]) + (v[j][2] * v[j][2] + v[j][3] * v[j][3]);
        const float rstd = 1.0f / sqrtf(wave_sum(s) * (1.0f / D) + EPS);
        const int mr = mod_row(row);
        if (!FINAL && xp && row >= MP) {
#pragma unroll
            for (int j = 0; j < 4; ++j) *(f32x4*)((float*)X + (size_t)row * D + 4 * lane + 256 * j) = v[j]; }
#pragma unroll
        for (int j = 0; j < 4; ++j) { const int col = 4 * lane + 256 * j; const f32x4 gg = *(const f32x4*)(g + col);
            if (FINAL) { *(f32x4*)(out + (size_t)row * D + col) = v[j] * rstd * gg; }
            else { const f32x4 s1 = *(const f32x4*)(sc + (size_t)mr * 6144 + col), s0 = *(const f32x4*)(sh + (size_t)mr * 6144 + col);
                const f32x4 h = v[j] * rstd * gg * (s1 + 1.0f) + s0;
                *(u32x2*)(XN + (size_t)row * D + col) = (u32x2){cvt_pk_bf16(h[0], h[1]), cvt_pk_bf16(h[2], h[3])}; } }
    }
}

constexpr int KS_PITCH = 144, VT_PITCH = 528, ATT_KS = 0, ATT_VT = 256 * KS_PITCH;
__device__ __forceinline__ void attn_prompt_unit(unsigned char* lds, const bf16_t* Q, const bf16_t* Kb, const bf16_t* Vb, bf16_t* MIX, const float* sinks, int unit, int tid) {
    const int kvh = unit & 1, nb = (unit >> 1) & 31, b = unit >> 6;
    const int wid = tid >> 6, lane = tid & 63;
    __syncthreads();
#pragma unroll
    for (int i = 0; i < 4; ++i) { const int ch = tid + 512 * i, kj = ch >> 3, c8 = ch & 7; const int tok = nb * 128 - 128 + kj;
        u32x4 kv = (u32x4){0u, 0u, 0u, 0u}, vv = kv;
        if (tok >= 0) { const size_t off = ((size_t)b * SEQ + tok) * 128 + kvh * 64 + c8 * 8; kv = *(const u32x4*)(Kb + off); vv = *(const u32x4*)(Vb + off); }
        *(u32x4*)(lds + ATT_KS + kj * KS_PITCH + c8 * 16) = kv;
        bf16_t* vt = (bf16_t*)(lds + ATT_VT) + kj;
#pragma unroll
        for (int j = 0; j < 4; ++j) { const unsigned w = vv[j]; vt[(size_t)(c8 * 8 + 2 * j) * (VT_PITCH / 2)] = (bf16_t)(w & 0xffffu); vt[(size_t)(c8 * 8 + 2 * j + 1) * (VT_PITCH / 2)] = (bf16_t)(w >> 16); } }
    __syncthreads();
    const int g = wid & 3, hh = wid >> 2, head = kvh * 4 + g, l32 = lane & 31, hi = lane >> 5;
    const float sink = sinks[head];
#pragma unroll 1
    for (int qs = 0; qs < 2; ++qs) {
        const int q0 = 64 * hh + 32 * qs, qi = q0 + l32;
        const size_t qrow = (size_t)b * SEQ + nb * 128 + qi;
        bf16x8 qf[4];
#pragma unroll
        for (int ks = 0; ks < 4; ++ks) qf[ks] = *(const bf16x8*)(Q + qrow * 512 + head * 64 + ks * 16 + hi * 8);
        f32x16 S[5];
#pragma unroll
        for (int kb = 0; kb < 5; ++kb) { f32x16 a = {0.f,0.f,0.f,0.f,0.f,0.f,0.f,0.f,0.f,0.f,0.f,0.f,0.f,0.f,0.f,0.f};
            const unsigned char* kp = lds + ATT_KS + (q0 + 32 * kb + l32) * KS_PITCH + hi * 16;
#pragma unroll
            for (int ks = 0; ks < 4; ++ks) { const bf16x8 kf = *(const bf16x8*)(kp + ks * 32); a = __builtin_amdgcn_mfma_f32_32x32x16_bf16(kf, qf[ks], a, 0, 0, 0); }
            S[kb] = a; }
        float mx = -1e30f;
#pragma unroll
        for (int kb = 0; kb < 5; ++kb)
#pragma unroll
            for (int r = 0; r < 16; ++r) { const int kj = q0 + 32 * kb + (r & 3) + 8 * (r >> 2) + 4 * hi; const int rel = 128 + qi - kj;
                const bool ok = (rel >= 0) && (rel < 128) && (nb > 0 || kj >= 128);
                const float s = ok ? S[kb][r] : -1e30f; S[kb][r] = s; mx = fmaxf(mx, s); }
        mx = fmaxf(xor32_max(mx), sink);
        float sum = 0.f;
#pragma unroll
        for (int kb = 0; kb < 5; ++kb)
#pragma unroll
            for (int r = 0; r < 16; ++r) { const float e = __expf(S[kb][r] - mx); S[kb][r] = e; sum += e; }
        sum = xor32_sum(sum) + __expf(sink - mx);
        const float inv = 1.0f / sum;
        bf16x8 P[5][2];
#pragma unroll
        for (int kb = 0; kb < 5; ++kb)
#pragma unroll
            for (int sl = 0; sl < 2; ++sl) { u32x4 w;
                w.x = cvt_pk_bf16(S[kb][8 * sl + 0] * inv, S[kb][8 * sl + 1] * inv); w.y = cvt_pk_bf16(S[kb][8 * sl + 2] * inv, S[kb][8 * sl + 3] * inv);
                w.z = cvt_pk_bf16(S[kb][8 * sl + 4] * inv, S[kb][8 * sl + 5] * inv); w.w = cvt_pk_bf16(S[kb][8 * sl + 6] * inv, S[kb][8 * sl + 7] * inv);
                P[kb][sl] = __builtin_bit_cast(bf16x8, w); }
#pragma unroll
        for (int db = 0; db < 2; ++db) { f32x16 o = {0.f,0.f,0.f,0.f,0.f,0.f,0.f,0.f,0.f,0.f,0.f,0.f,0.f,0.f,0.f,0.f};
            const unsigned char* vp = lds + ATT_VT + (32 * db + l32) * VT_PITCH + (q0 + 4 * hi) * 2;
#pragma unroll
            for (int kb = 0; kb < 5; ++kb)
#pragma unroll
                for (int sl = 0; sl < 2; ++sl) { const u32x2 lo = *(const u32x2*)(vp + (32 * kb + 16 * sl) * 2), hi2 = *(const u32x2*)(vp + (32 * kb + 16 * sl + 8) * 2);
                    const bf16x8 vf = __builtin_bit_cast(bf16x8, (u32x4){lo.x, lo.y, hi2.x, hi2.y});
                    o = __builtin_amdgcn_mfma_f32_32x32x16_bf16(vf, P[kb][sl], o, 0, 0, 0); }
            bf16_t* op = MIX + qrow * 1024 + head * 64 + 32 * db + 4 * hi;
#pragma unroll
            for (int r4 = 0; r4 < 4; ++r4) *(u32x2*)(op + 8 * r4) = (u32x2){cvt_pk_bf16(o[4 * r4], o[4 * r4 + 1]), cvt_pk_bf16(o[4 * r4 + 2], o[4 * r4 + 3])}; }
    }
}

__device__ __forceinline__ void attn_sample_wave(float* wl  , const bf16_t* Q, const bf16_t* Kb, const bf16_t* Vb, const float* ck, const float* cv, bf16_t* MIX, const float* sinks, int task, int lane) {
    const int g = task & 3, kvh = (task >> 2) & 1, b = task >> 3, head = kvh * 4 + g;
    float* qs = wl; float* ps = wl + 256;
#pragma unroll
    for (int t = 0; t < 4; ++t) qs[t * 64 + lane] = bf2f(Q[(size_t)(MP + b * 4 + t) * 512 + head * 64 + lane]);
    asm volatile("s_waitcnt lgkmcnt(0)" ::: "memory");
    float sc[3][4];
#pragma unroll
    for (int slot = 0; slot < 3; ++slot) {
        const int j = slot * 64 + lane; const bool have = (slot < 2) || (lane < 4);
        float d0 = 0.f, d1 = 0.f, d2 = 0.f, d3 = 0.f;
        if (have) {
            if (slot < 2) { const float* kr = ck + ((size_t)b * 128 + j) * 128 + kvh * 64;
#pragma unroll 8
                for (int d4 = 0; d4 < 16; ++d4) { const f32x4 kv = *(const f32x4*)(kr + 4 * d4);
#pragma unroll
                    for (int i = 0; i < 4; ++i) { const int d = 4 * d4 + i; d0 += kv[i] * qs[d]; d1 += kv[i] * qs[64 + d]; d2 += kv[i] * qs[128 + d]; d3 += kv[i] * qs[192 + d]; } }
            } else { const bf16_t* kr = Kb + (size_t)(MP + b * 4 + lane) * 128 + kvh * 64;
#pragma unroll 16
                for (int d = 0; d < 64; ++d) { const float kv = bf2f(kr[d]); d0 += kv * qs[d]; d1 += kv * qs[64 + d]; d2 += kv * qs[128 + d]; d3 += kv * qs[192 + d]; } }
        }
        const float dd[4] = {d0, d1, d2, d3};
#pragma unroll
        for (int t = 0; t < 4; ++t) { const bool ok = have && ((slot < 2) ? (j > t) : (lane <= t)); sc[slot][t] = ok ? dd[t] : -1e30f; }
    }
    const float sink = sinks[head];
#pragma unroll
    for (int t = 0; t < 4; ++t) {
        float mx = fmaxf(fmaxf(sc[0][t], sc[1][t]), sc[2][t]); mx = fmaxf(wave_max(mx), sink);
        const float e0 = __expf(sc[0][t] - mx), e1 = __expf(sc[1][t] - mx), e2 = __expf(sc[2][t] - mx);
        const float sum = wave_sum(e0 + e1 + e2) + __expf(sink - mx); const float inv = 1.0f / sum;
        ps[t * 132 + lane] = e0 * inv; ps[t * 132 + 64 + lane] = e1 * inv; if (lane < 4) ps[t * 132 + 128 + lane] = e2 * inv;
    }
    asm volatile("s_waitcnt lgkmcnt(0)" ::: "memory");
    float o0 = 0.f, o1 = 0.f, o2 = 0.f, o3 = 0.f;
    const float* vr = cv + (size_t)b * 128 * 128 + kvh * 64 + lane;
#pragma unroll 1
    for (int j0 = 0; j0 < 128; j0 += 32) { float vv[32];
#pragma unroll
        for (int jj = 0; jj < 32; ++jj) vv[jj] = vr[(size_t)(j0 + jj) * 128];
#pragma unroll
        for (int jj = 0; jj < 32; ++jj) { const int j = j0 + jj; const float v = vv[jj]; o0 += ps[j] * v; o1 += ps[132 + j] * v; o2 += ps[264 + j] * v; o3 += ps[396 + j] * v; } }
#pragma unroll
    for (int j = 0; j < 4; ++j) { const float v = bf2f(Vb[(size_t)(MP + b * 4 + j) * 128 + kvh * 64 + lane]); o0 += ps[128 + j] * v; o1 += ps[132 + 128 + j] * v; o2 += ps[264 + 128 + j] * v; o3 += ps[396 + 128 + j] * v; }
    bf16_t* op = MIX + (size_t)(MP + b * 4) * 1024 + head * 64 + lane;
    op[0] = f2bf(o0); op[1024] = f2bf(o1); op[2048] = f2bf(o2); op[3072] = f2bf(o3);
    asm volatile("s_waitcnt lgkmcnt(0)" ::: "memory");
}

__device__ __forceinline__ void conv_group(const bf16_t* VC, size_t vrow0  , int tvalid0  , const float* hist,
                                           const float* cw, const float* cb, const float* lg, const float* lb, bf16_t* MIX, size_t orow0, int lane) {
    const int c4 = lane * 4;
    u32x2 vr[34];
#pragma unroll
    for (int r = 0; r < 34; ++r) {
        if (hist && r < 30) { const f32x4 h = *(const f32x4*)(hist + (size_t)r * 256 + c4); vr[r] = (u32x2){cvt_pk_bf16(h[0], h[1]), cvt_pk_bf16(h[2], h[3])}; }
        else if (r < tvalid0) vr[r] = (u32x2){0u, 0u};
        else vr[r] = *(const u32x2*)(VC + (vrow0 + r - 30) * 256 + c4);
    }
    const f32x4 bias = *(const f32x4*)(cb + c4);
    f32x4 acc[4] = {bias, bias, bias, bias};
#pragma unroll
    for (int k = 0; k < 31; ++k) { const f32x4 w = *(const f32x4*)(cw + (size_t)k * 256 + c4);
#pragma unroll
        for (int jj = 0; jj < 4; ++jj) { const u32x2 v = vr[k + jj]; acc[jj] += w * (f32x4){bflo(v.x), bfhi(v.x), bflo(v.y), bfhi(v.y)}; } }
    const f32x4 gg = *(const f32x4*)(lg + c4), bb = *(const f32x4*)(lb + c4);
#pragma unroll
    for (int jj = 0; jj < 4; ++jj) { const f32x4 a = acc[jj];
        const float mean = wave_sum((a[0] + a[1]) + (a[2] + a[3])) * (1.0f / 256.0f);
        const f32x4 dl = a - mean; const float var = wave_sum((dl[0] * dl[0] + dl[1] * dl[1]) + (dl[2] * dl[2] + dl[3] * dl[3])) * (1.0f / 256.0f);
        const float rstd = 1.0f / sqrtf(var + EPS); f32x4 y = dl * rstd * gg + bb;
#pragma unroll
        for (int i = 0; i < 4; ++i) y[i] = y[i] * sigmoidf_(y[i]);
        *(u32x2*)(MIX + (orow0 + jj) * 1024 + 768 + c4) = (u32x2){cvt_pk_bf16(y[0], y[1]), cvt_pk_bf16(y[2], y[3])}; }
}

__device__ __forceinline__ void ssm_sample_wave(float* wl  , const float* ZUS, const float* sre, const float* sim, const float* apow, const float* bbt,
                                                const float* cre, const float* cim, const float* dsk, bf16_t* Z, float* ore, float* oim, int task, int lane) {
    const int g = task & 15, b = task >> 4, p = lane;
    const float ar = apow[((g * 17 + 1) * 64 + p) * 2], aim = apow[((g * 17 + 1) * 64 + p) * 2 + 1];
    float hr = sre[((size_t)b * 16 + g) * 64 + p], hi = sim[((size_t)b * 16 + g) * 64 + p];
    const float* bp = bbt + ((size_t)g * 64 + p) * 32;
    f32x4 bpv[8];
#pragma unroll
    for (int c4 = 0; c4 < 8; ++c4) bpv[c4] = *(const f32x4*)(bp + 4 * c4);
#pragma unroll
    for (int t = 0; t < 4; ++t) { const float* u = ZUS + (size_t)(b * 4 + t) * 256 + g * 16; float br = 0.f, bi = 0.f;
#pragma unroll
        for (int c4 = 0; c4 < 4; ++c4) { const f32x4 uv = *(const f32x4*)(u + 4 * c4);
#pragma unroll
            for (int i = 0; i < 4; ++i) { const int c = 4 * c4 + i; br += bpv[c >> 1][(c & 1) * 2] * uv[i]; bi += bpv[c >> 1][(c & 1) * 2 + 1] * uv[i]; } }
        const float nr = ar * hr - aim * hi + br, ni = ar * hi + aim * hr + bi; hr = nr; hi = ni;
        wl[t * 128 + p] = hr; wl[t * 128 + 64 + p] = hi; }
    ore[((size_t)b * 16 + g) * 64 + p] = hr; oim[((size_t)b * 16 + g) * 64 + p] = hi;
    asm volatile("s_waitcnt lgkmcnt(0)" ::: "memory");
    const int t = lane >> 4, cp = lane & 15;
    const float* cr = cre + ((size_t)g * 16 + cp) * 64; const float* ci = cim + ((size_t)g * 16 + cp) * 64;
    float y = 0.f;
    f32x4 crv[16], civ[16];
#pragma unroll
    for (int q4 = 0; q4 < 16; ++q4) { crv[q4] = *(const f32x4*)(cr + 4 * q4); civ[q4] = *(const f32x4*)(ci + 4 * q4); }
#pragma unroll
    for (int q4 = 0; q4 < 16; ++q4) { const f32x4 hr4 = *(const f32x4*)(wl + t * 128 + 4 * q4), hi4 = *(const f32x4*)(wl + t * 128 + 64 + 4 * q4);
#pragma unroll
        for (int i = 0; i < 4; ++i) y += crv[q4][i] * hr4[i] - civ[q4][i] * hi4[i]; }
    y += dsk[g * 16 + cp] * ZUS[(size_t)(b * 4 + t) * 256 + g * 16 + cp];
    Z[(size_t)(MP + b * 4 + t) * 256 + g * 16 + cp] = f2bf(gelu_tanh(y));
    asm volatile("s_waitcnt lgkmcnt(0)" ::: "memory");
}

__device__ __forceinline__ const void* ld_ptr(unsigned pb, int i) { const unsigned long long v = *(const LAS unsigned long long*)(pb + 8u * (unsigned)i);
    const unsigned lo = __builtin_amdgcn_readfirstlane((unsigned)v), hi = __builtin_amdgcn_readfirstlane((unsigned)(v >> 32));
    typedef __attribute__((address_space(1))) const void* gptr_t; return (const void*)(gptr_t)(((unsigned long long)hi << 32) | lo); }
constexpr int PTAB_OFF = 131072 + 1024;
#define XB_TMO      128
#define XB_XCNT(j)  (256  + 64 * (j))
#define XB_XSUB(j)  (1280 + 64 * (j))
#define XB_XGEN(j)  (2304 + 64 * (j))
#define XB_TOP      3328
#define XB_TOPGEN   3392
#define XCD_BAR_WORDS 3456
#define XB_SPIN_CAP (1u << 20)
__device__ __forceinline__ unsigned xb_ld(unsigned* p)              { return __hip_atomic_load(p, __ATOMIC_RELAXED, __HIP_MEMORY_SCOPE_AGENT); }
__device__ __forceinline__ unsigned xb_add(unsigned* p, unsigned v) { return __hip_atomic_fetch_add(p, v, __ATOMIC_RELAXED, __HIP_MEMORY_SCOPE_AGENT); }
__device__ __forceinline__ unsigned xb_xcc_id() { return (unsigned)__builtin_amdgcn_s_getreg((3 << 11) | 20) & 0xFu; }
#define XB_SPIN(cond, bar) do { unsigned _sp = 0; while (cond) { __builtin_amdgcn_s_sleep(1); \
    if ((++_sp & 255u) == 0u) { if (xb_ld(&(bar)[XB_TMO])) break; if (_sp > XB_SPIN_CAP) { atomicAdd(&(bar)[XB_TMO], 1u); break; } } } } while (0)
constexpr int XBST_OFF = PTAB_OFF + 512;
__device__ __forceinline__ void xcd_barrier_complete(unsigned* bar, unsigned x, unsigned G, unsigned& nloc, unsigned& nx) {
    unsigned sum, cnt, mine, sp = 0u;
    for (;;) {
        sum = 0u; cnt = 0u; mine = 0u;
#pragma unroll
        for (unsigned j = 0; j < 16; ++j) { const unsigned c = xb_ld(&bar[XB_XCNT(j)]); sum += c; cnt += (c > 0u) ? 1u : 0u; mine = (j == x) ? c : mine; }
        if (sum == G) break;
        __builtin_amdgcn_s_sleep(1);
        if ((++sp & 255u) == 0u) { if (xb_ld(&bar[XB_TMO])) break; if (sp > XB_SPIN_CAP) { atomicAdd(&bar[XB_TMO], 1u); break; } }
    }
    nloc = mine > 0u ? mine : 1u; nx = cnt > 0u ? cnt : 1u;
}
__device__ __forceinline__ void grid_barrier(unsigned* bar, unsigned G, int tid, volatile LAS unsigned* st) {
    asm volatile("s_waitcnt vmcnt(0) lgkmcnt(0)" ::: "memory");
    __syncthreads();
    if (tid == 0) {
        const unsigned x = xb_xcc_id();
        unsigned nloc = st[0], nx = st[1];
        if (nloc == 0u) { xcd_barrier_complete(bar, x, G, nloc, nx); st[0] = nloc; st[1] = nx; }
        const unsigned old = xb_add(&bar[XB_XSUB(x)], 1u);
        const unsigned gen = old / nloc;
        if (old + 1u == (gen + 1u) * nloc) {
            __builtin_amdgcn_fence(__ATOMIC_RELEASE, "agent");
            asm volatile("s_waitcnt vmcnt(0)" ::: "memory");
            const unsigned og = xb_add(&bar[XB_TOP], 1u);
            const unsigned tg = og / nx;
            if (og + 1u == (tg + 1u) * nx) xb_add(&bar[XB_TOPGEN], 1u);
            else XB_SPIN(xb_ld(&bar[XB_TOPGEN]) == tg, bar);
            __builtin_amdgcn_fence(__ATOMIC_ACQUIRE, "agent");
            xb_add(&bar[XB_XGEN(x)], 1u);
            asm volatile("s_waitcnt vmcnt(0)" ::: "memory");
        } else {
            XB_SPIN(xb_ld(&bar[XB_XGEN(x)]) == gen, bar);
            __builtin_amdgcn_fence(__ATOMIC_ACQUIRE, "agent");
            asm volatile("s_waitcnt vmcnt(0)" ::: "memory");
        }
    }
    __syncthreads();
}
__global__ void __launch_bounds__(512, 2) hybrid_fwd(Params P) {
    extern __shared__ __attribute__((aligned(16))) unsigned char lds[];
    LAS unsigned char* ldsl = (LAS unsigned char*)lds;
    const int G0 = gridDim.x, bid0 = blockIdx.x;
    const int wave0 = __builtin_amdgcn_readfirstlane((int)threadIdx.x >> 6);
#if !MK_LAUNCH_PER_PHASE
    cg::this_grid().sync();
#endif
    LAS unsigned long long* ptab = (LAS unsigned long long*)(ldsl + PTAB_OFF);
    if (threadIdx.x == 0) {
#pragma unroll
        for (int i = 0; i < 34; ++i) ptab[i] = (unsigned long long)P.in[i];
        ptab[34] = (unsigned long long)P.out; ptab[35] = (unsigned long long)P.ws;
        ((volatile LAS unsigned*)(ldsl + XBST_OFF))[0] = 0u; ((volatile LAS unsigned*)(ldsl + XBST_OFF))[1] = 0u;
        (void)xb_add((unsigned*)P.ws + XB_XCNT(xb_xcc_id()), 1u); }
    __syncthreads();
#define INP(i) ((const float*)ld_ptr(pb, (i)))
#define ROPE ((float*)(ws + WS_ROPE))
#define SC ((bf16_t*)(ws + WS_SC))
#define APOW ((float*)(ws + WS_APOW))
#define BB ((float*)(ws + WS_BB))
#define MOD ((float*)(ws + WS_MOD))
#define WGLU ((bf16_t*)(ws + WS_WGLU))
#define BTE ((bf16_t*)(ws + WS_BTE))
#define BTY ((bf16_t*)(ws + WS_BTY))
#define WIN ((bf16_t*)(ws + WS_WIN))
#define WOUT ((bf16_t*)(ws + WS_WOUT))
#define WGU ((bf16_t*)(ws + WS_WGU))
#define WDN ((bf16_t*)(ws + WS_WDN))
#define X ((float*)(ws + WS_X))
#define XN ((bf16_t*)(ws + WS_XN))
#define Hb ((bf16_t*)(ws + WS_H))
#define MIX ((bf16_t*)(ws + WS_MIX))
#define Qb ((bf16_t*)(ws + WS_Q))
#define Kb ((bf16_t*)(ws + WS_K))
#define Vb ((bf16_t*)(ws + WS_V))
#define ZUT ((bf16_t*)(ws + WS_ZUT))
#define VC ((bf16_t*)(ws + WS_VC))
#define Zb ((bf16_t*)(ws + WS_Z))
#define ZUS ((float*)(ws + WS_ZUS))
#define WMOD ((bf16_t*)(ws + WS_WMOD))
    const int lo = P.ph_lo, hi = P.ph_hi;
    int ph = 0;
#define PHASE_BEGIN if (ph >= lo && ph < hi) { int lane; asm volatile("v_mbcnt_lo_u32_b32 %0, -1, 0\n\tv_mbcnt_hi_u32_b32 %0, -1, %0" : "=v"(lane)); int G = G0, bid = bid0; asm volatile("" : "+s"(G), "+s"(bid)); const int NGW = G * 8, NGT = G * 512; (void)NGW; (void)NGT; int wave = wave0; asm volatile("" : "+s"(wave)); const int tid = wave * 64 + lane, gw = bid * 8 + wave, gt = bid * 512 + tid; (void)lane; (void)gw; (void)gt; \
    unsigned pb = (unsigned)(size_t)ptab; asm volatile("" : "+v"(pb)); unsigned char* const ws = (unsigned char*)ld_ptr(pb, 35); float* const out = (float*)ld_ptr(pb, 34); (void)out;
#if MK_LAUNCH_PER_PHASE
#define PHASE_END } ++ph;
#else
#define PHASE_END if (ph + 1 < hi) grid_barrier((unsigned*)ws, (unsigned)G, tid, (volatile LAS unsigned*)(ldsl + XBST_OFF)); } ++ph;
#endif

    PHASE_BEGIN
    {
        for (int i = gt; i < 4100 * 32; i += NGT) { const int idx = i >> 5, d = i & 31; const int pos = idx < 4096 ? idx : 8192 + (idx - 4096);
            const double invf = exp(-(double)d * (9.210340371976184 / 32.0)); float c, s; cis_rev((double)pos * invf, c, s); ROPE[idx * 64 + d] = c; ROPE[idx * 64 + 32 + d] = s; }
        { const float* cpr = INP(2); const float* csm = INP(3);
        for (int i = gt; i < 256 * 1024; i += NGT) { const int r = i >> 10, c = i & 1023; float v = 0.f;
            if (r < NPB) v = cpr[r * 1024 + c]; else if (r < NMODROWS) v = csm[(r - NPB) * 1024 + c];
            SC[i] = f2bf(v * sigmoidf_(v)); } }
        for (int i = gt; i < DEPTH * 16 * 17 * 64; i += NGT) { const int p = i & 63, k = (i >> 6) % 17, lg = i / (64 * 17);
            const float dt = __expf(INP(17)[lg]); const float lr = INP(15)[lg * 64 + p], li = INP(16)[lg * 64 + p];
            const float th = li * dt; float c, s; cis_rev((double)th * (double)k, c, s); const float mag = expf((float)k * (lr * dt));
            APOW[(size_t)i * 2] = mag * c; APOW[(size_t)i * 2 + 1] = mag * s; }
        for (int i = gt; i < DEPTH * 16 * 64 * 16; i += NGT) { const int c = i & 15, p = (i >> 4) & 63, lg = i >> 10;
            const float dt = __expf(INP(17)[lg]); const float lr = INP(15)[lg * 64 + p], li = INP(16)[lg * 64 + p];
            float cc, ss; cis_rev((double)(li * dt), cc, ss); const float mag = expf(lr * dt); const float abr = mag * cc, abi = mag * ss;
            const float den = lr * lr + li * li, nr = abr - 1.0f; const float cr = (nr * lr + abi * li) / den, ci = (abi * lr - nr * li) / den;
            const float br = INP(18)[(size_t)(lg * 64 + p) * 16 + c], bi = INP(19)[(size_t)(lg * 64 + p) * 16 + c];
            BB[(size_t)i * 2] = cr * br - ci * bi; BB[(size_t)i * 2 + 1] = cr * bi + ci * br; }
        { const float* ckp = INP(4); const float* cvp = INP(5); const float* scp = INP(8);
#pragma unroll 4
        for (int i = gt; i < DEPTH * NSB * 124 * 32; i += NGT) { const int c4 = i & 31, r = (i >> 5) % 124, lb = i / (32 * 124);
            const size_t src = ((size_t)lb * 128 + r + 4) * 128 + c4 * 4, dst = ((size_t)lb * 128 + r) * 128 + c4 * 4;
            *(f32x4*)(out + O_KS + dst) = *(const f32x4*)(ckp + src); *(f32x4*)(out + O_VS + dst) = *(const f32x4*)(cvp + src); }
#pragma unroll 4
        for (int i = gt; i < DEPTH * NSB * 26 * 64; i += NGT) { const int c4 = i & 63, r = (i >> 6) % 26, lb = i / (64 * 26);
            *(f32x4*)(out + O_CS + ((size_t)lb * 30 + r) * 256 + c4 * 4) = *(const f32x4*)(scp + ((size_t)lb * 30 + r + 4) * 256 + c4 * 4); } }
        float* scr = (float*)(lds + wave * 16384);
        constexpr int I_IN = 16 * 48, I_OUT = 16 * 32, I_G = 16 * 88, I_DN = 44 * 32, I_GLU = 4 * 8, I_MOD = 16 * 192;
        constexpr int I_LAYER = I_IN + I_OUT + 2 * I_G + I_DN + I_GLU + I_MOD;
        for (int it = gw; it < DEPTH * I_LAYER; it += NGW) {
            const int l = it / I_LAYER; int r = it % I_LAYER;
            if (r < I_IN) { const int kb = r / 48, nbk = r % 48; transpose_item(INP(13) + (size_t)l * D * NIN, D, NIN, WIN + (size_t)l * NIN * D, nbk * 32, kb * 64, win_dst_row(nbk * 32), scr, lane); continue; } r -= I_IN;
            if (r < I_OUT) { const int kb = r / 32, nbk = r % 32; transpose_item(INP(29) + (size_t)l * D * D, D, D, WOUT + (size_t)l * D * D, nbk * 32, kb * 64, nbk * 32, scr, lane); continue; } r -= I_OUT;
            if (r < I_G) { const int kb = r / 88, nbk = r % 88, n0 = nbk * 32; transpose_item(INP(30) + (size_t)l * D * DFF, D, DFF, WGU + (size_t)l * NGU * D, n0, kb * 64, 256 * (n0 >> 7) + (n0 & 127), scr, lane); continue; } r -= I_G;
            if (r < I_G) { const int kb = r / 88, nbk = r % 88, n0 = nbk * 32; transpose_item(INP(31) + (size_t)l * D * DFF, D, DFF, WGU + (size_t)l * NGU * D, n0, kb * 64, 256 * (n0 >> 7) + 128 + (n0 & 127), scr, lane); continue; } r -= I_G;
            if (r < I_DN) { const int kb = r / 32, nbk = r % 32; transpose_item(INP(32) + (size_t)l * DFF * D, DFF, D, WDN + (size_t)l * D * DFF, nbk * 32, kb * 64, nbk * 32, scr, lane); continue; } r -= I_DN;
            if (r < I_GLU) { const int kb = r / 8, nbk = r % 8; transpose_item(INP(23) + (size_t)l * 65536, 256, 256, WGLU + (size_t)l * 65536, nbk * 32, kb * 64, nbk * 32, scr, lane); continue; } r -= I_GLU;
            { const int kb = r / 192, nbk = r % 192; transpose_item(INP(11) + (size_t)l * D * 6144, D, 6144, WMOD + (size_t)l * 6144 * D, nbk * 32, kb * 64, nbk * 32, scr, lane); }
        }
    }
    PHASE_END

    PHASE_BEGIN
    {
        if (bid >= 96) {
        const int gt = (bid - 96) * 512 + tid, NGT = (G - 96) * 512;
        for (int i = gt; i < DEPTH * 16 * 31 * 256; i += NGT) { const int c = i & 15, cp = (i >> 4) & 15, ti = (i >> 8) % 31, lg = i / (256 * 31); const int tau = ti - 15;
            bf16_t* by = BTY + (size_t)lg * 256 * KY;
            if (tau < 0) { for (int t = 0; t <= 15 + tau; ++t) by[(size_t)(t * 16 + cp) * KY + (t - tau) * 16 + c] = 0; }
            else { const float* ap = APOW + ((size_t)lg * 17 + tau) * 128; const float* bp = BB + (size_t)lg * 64 * 32 + c * 2;
                const float* cr = INP(20) + ((size_t)lg * 16 + cp) * 64; const float* ci = INP(21) + ((size_t)lg * 16 + cp) * 64;
                float acc = 0.f;
                for (int p = 0; p < 64; ++p) { const float ar = ap[2 * p], ai = ap[2 * p + 1], br = bp[p * 32], bi = bp[p * 32 + 1];
                    const float wr_ = ar * br - ai * bi, wi_ = ar * bi + ai * br; acc += cr[p] * wr_ - ci[p] * wi_; }
                if (tau == 0 && c == cp) acc += INP(22)[lg * 16 + c];
                const bf16_t v = f2bf(acc);
                for (int t = tau; t < 16; ++t) by[(size_t)(t * 16 + cp) * KY + (t - tau) * 16 + c] = v; } }
        for (int i = gt; i < DEPTH * 16 * 16 * 16 * 64; i += NGT) { const int p = i & 63, cp = (i >> 6) & 15, t = (i >> 10) & 15, lg = i >> 14;
            const float ar = APOW[(((size_t)lg * 17 + t + 1) * 64 + p) * 2], ai = APOW[(((size_t)lg * 17 + t + 1) * 64 + p) * 2 + 1];
            const float cr = INP(20)[((size_t)lg * 16 + cp) * 64 + p], ci = INP(21)[((size_t)lg * 16 + cp) * 64 + p];
            bf16_t* by = BTY + ((size_t)lg * 256 + t * 16 + cp) * KY + 256; by[p] = f2bf(cr * ar - ci * ai); by[64 + p] = f2bf(-(cr * ai + ci * ar)); }
        for (int i = gt; i < DEPTH * 16 * 64 * 256; i += NGT) { const int c = i & 15, s = (i >> 4) & 15, p = (i >> 8) & 63, lg = i >> 14;
            const float ar = APOW[(((size_t)lg * 17 + 15 - s) * 64 + p) * 2], ai = APOW[(((size_t)lg * 17 + 15 - s) * 64 + p) * 2 + 1];
            const float br = BB[(((size_t)lg * 64 + p) * 16 + c) * 2], bi = BB[(((size_t)lg * 64 + p) * 16 + c) * 2 + 1];
            bf16_t* be = BTE + ((size_t)lg * 128 + p) * 256 + s * 16 + c; be[0] = f2bf(ar * br - ai * bi); be[(size_t)64 * 256] = f2bf(ar * bi + ai * br); }
        }
        __syncthreads();
        pg8::Gemm g{SC, WMOD, D, D, D, 0, (size_t)6144 * D * 2}; pg8::Order S; S.init(1, 24, DEPTH, G, bid, D / 64);
        EpiMod E{MOD, INP(12)};
        pg8::gemm_phase<EpiMod, true>(ldsl, g, S, E, wave);
    }
    PHASE_END

    PHASE_BEGIN
    norm_rows<false>(INP(0), INP(1), X, INP(9), MOD, MOD + 1024, XN, out, gw, NGW, lane, nullptr, 0);
    PHASE_END

#define MIX_TASK(task) do { if (task < 256) attn_prompt_unit(lds, Qb, Kb, Vb, MIX, sinks, task, tid); else if (task < 384) { __syncthreads(); attn_sample_wave((float*)(lds + wave * 4096), Qb, Kb, Vb, INP(4) + (size_t)l * NSB * 128 * 128, INP(5) + (size_t)l * NSB * 128 * 128, MIX, sinks, (task - 256) * 8 + wave, lane); } else if (task < 640) { __syncthreads(); ssm_sample_wave((float*)(lds + wave * 4096), ZUS, INP(6) + (size_t)l * NSB * 1024, INP(7) + (size_t)l * NSB * 1024, APOW + (size_t)l * 16 * 17 * 128, BB + (size_t)l * 16 * 64 * 32, INP(20) + (size_t)l * 16384, INP(21) + (size_t)l * 16384, INP(22) + l * 256, Zb, out + O_RS + (size_t)l * 131072, out + O_IS + (size_t)l * 131072, (task - 384) * 8 + wave, lane); } else if (task < 896) { const int tk = task - 640; _Pragma("unroll 1") for (int it = 0; it < 2; ++it) { const int tok = tk * 64 + (it * 8 + wave) * 4, t = tok & 4095; conv_group(VC, (size_t)tok, 30 - t, nullptr, INP(25) + (size_t)l * 31 * 256, INP(26) + l * 256, INP(27) + l * 256, INP(28) + l * 256, MIX, (size_t)tok, lane); } } else { const int b = (task - 896) * 8 + wave; conv_group(VC, (size_t)MP + b * 4, 0, INP(8) + ((size_t)l * NSB + b) * 30 * 256, INP(25) + (size_t)l * 31 * 256, INP(26) + l * 256, INP(27) + l * 256, INP(28) + l * 256, MIX, (size_t)MP + b * 4, lane); } } while (0)
#pragma unroll 1
    for (int l = 0; l < DEPTH; ++l) {
        PHASE_BEGIN
        {
            pg8::Gemm g{XN, WIN + (size_t)l * NIN * D, D, D, D, 0, 0}; pg8::Order S; S.init(M / 256, NIN / 256, 1, G, bid, D / 64);
            EpiIn E{Qb, Kb, Vb, ZUT, VC, ZUS, ROPE, out, l};
            pg8::gemm_phase<EpiIn, true>(ldsl, g, S, E, wave);
        }
        PHASE_END
        PHASE_BEGIN
        {
            const int NE = 64;
            if (bid < NE) {
                pg8::Gemm g{ZUT, BTE + (size_t)l * 16 * 128 * 256, 256, KY, 256, (size_t)NCHUNK * KY * 2, (size_t)128 * 256 * 2}; pg8::Order S; S.init(4, 1, 16, NE, bid, 4);
                EpiE E{ZUT, APOW + (size_t)l * 16 * 17 * 128, out + O_RP + (size_t)l * 4096, out + O_IP + (size_t)l * 4096};
                pg8::gemm_phase<EpiE, false>(ldsl, g, S, E, wave);
            }
            {
                const float* sinks = INP(14) + l * 8;
                for (int i = bid; i < 256; i += G) { const int task = i; MIX_TASK(task); }
                if (bid >= NE) for (int i = bid - NE; i < 256; i += G - NE) { const int task = 384 + i; MIX_TASK(task); }
                __syncthreads();
            }
        }
        PHASE_END
        PHASE_BEGIN
        {
            if (bid < 64) {
                pg8::Gemm g{ZUT, BTY + (size_t)l * 16 * 256 * KY, KY, KY, KY, (size_t)NCHUNK * KY * 2, (size_t)256 * KY * 2}; pg8::Order S; S.init(4, 1, 16, 64, bid, KY / 64);
                EpiY E{Zb};
                pg8::gemm_phase<EpiY, true>(ldsl, g, S, E, wave);
                {
#pragma unroll 1
                    for (int it = 0; it < 2; ++it) { const int tok = bid * 64 + (it * 8 + wave) * 4, t = tok & 4095;
                        conv_group(VC, (size_t)tok, 30 - t, nullptr, INP(25) + (size_t)l * 31 * 256, INP(26) + l * 256, INP(27) + l * 256, INP(28) + l * 256, MIX, (size_t)tok, lane); } }
            } else {
                const float* sinks = INP(14) + l * 8;
                for (int i = bid - 64; i < 336; i += G - 64) { const int task = i < 128 ? 256 + i : 576 + i; MIX_TASK(task); }
                __syncthreads();
            }
        }
        PHASE_END
        PHASE_BEGIN
        {
            pg8::Gemm g{Zb, WGLU + (size_t)l * 65536, 256, 256, 256, 0, 0}; pg8::Order S; S.init(M / 256, 1, 1, G, bid, 4);
            EpiGlu E{Zb, MIX, INP(24) + l * 256};
            pg8::gemm_phase<EpiGlu, true>(ldsl, g, S, E, wave);
        }
        PHASE_END
        PHASE_BEGIN
        {
            pg8::Gemm g{MIX, WOUT + (size_t)l * D * D, D, D, D, 0, 0}; pg8::Order S; S.init_split(MP / 256, MS / 256, D / 256, G, bid, D / 64);
            EpiRes E{l == 0 ? INP(0) : nullptr, INP(1), X, (MOD + (size_t)l * NMODROWS * 6144) + 2048, (float*)(ws + WS_PART)};
            pg8::gemm_phase<EpiRes, true>(ldsl, g, S, E, wave);
        }
        PHASE_END
        PHASE_BEGIN
        norm_rows<false>(nullptr, nullptr, X, INP(10) + l * D, (MOD + (size_t)l * NMODROWS * 6144) + 3072, (MOD + (size_t)l * NMODROWS * 6144) + 4096, XN, nullptr, gw, NGW, lane, (const float*)(ws + WS_PART), D / 256);
        PHASE_END
        PHASE_BEGIN
        {
            pg8::Gemm g{XN, WGU + (size_t)l * NGU * D, D, D, D, 0, 0}; pg8::Order S; S.init(M / 256, NGU / 256, 1, G, bid, D / 64);
            EpiGU E{Hb};
            pg8::gemm_phase<EpiGU, true>(ldsl, g, S, E, wave);
        }
        PHASE_END
        PHASE_BEGIN
        {
            pg8::Gemm g{Hb, WDN + (size_t)l * D * DFF, DFF, DFF, DFF, 0, 0}; pg8::Order S; S.init_split(MP / 256, MS / 256, D / 256, G, bid, DFF / 64);
            EpiRes E{nullptr, nullptr, X, (MOD + (size_t)l * NMODROWS * 6144) + 5120, (float*)(ws + WS_PART)};
            pg8::gemm_phase<EpiRes, true>(ldsl, g, S, E, wave);
        }
        PHASE_END
        PHASE_BEGIN
        if (l + 1 < DEPTH) norm_rows<false>(nullptr, nullptr, X, INP(9) + (l + 1) * D, (MOD + (size_t)l * NMODROWS * 6144) + (size_t)NMODROWS * 6144, (MOD + (size_t)l * NMODROWS * 6144) + (size_t)NMODROWS * 6144 + 1024, XN, nullptr, gw, NGW, lane, (const float*)(ws + WS_PART), DFF / 256);
        else norm_rows<true>(nullptr, nullptr, X, INP(33), nullptr, nullptr, nullptr, out, gw, NGW, lane, (const float*)(ws + WS_PART), DFF / 256);
        PHASE_END
    }
}
constexpr int N_PHASES = 3 + 9 * DEPTH;
#ifndef PH_LIMIT
#define PH_LIMIT N_PHASES
#endif

extern "C" void kernel_launch(void* const* d_in, const int* in_sizes, int n_in, void* d_out, int out_size, void* d_ws, size_t ws_size, hipStream_t stream) {
    static int grid = 0;
    if (grid == 0) {
        if (n_in != 34 || (size_t)out_size != O_END || ws_size < WS_END) { fprintf(stderr, "kernel_launch: unexpected sizes n_in %d out %d ws %zu\n", n_in, out_size, ws_size); grid = -1; return; }
        int dev = 0, cus = 0, per_cu = 0;
        hipGetDevice(&dev); hipDeviceGetAttribute(&cus, hipDeviceAttributeMultiprocessorCount, dev);
        hipFuncSetAttribute((const void*)hybrid_fwd, hipFuncAttributeMaxDynamicSharedMemorySize, LDS_BYTES);
        hipOccupancyMaxActiveBlocksPerMultiprocessor(&per_cu, (const void*)hybrid_fwd, 512, LDS_BYTES);
        if (per_cu < 1) { fprintf(stderr, "kernel_launch: occupancy query says %d blocks per CU\n", per_cu); per_cu = 1; }
        grid = cus * per_cu; if (grid < 128) { fprintf(stderr, "kernel_launch: grid %d too small\n", grid); grid = -1; return; }
        fprintf(stderr, "kernel_launch: grid %d (cus %d x %d)\n", grid, cus, per_cu);
    }
    if (grid < 0) return;
    if (hipMemsetAsync(d_ws, 0, XCD_BAR_WORDS * 4, stream) != hipSuccess) { fprintf(stderr, "kernel_launch: memset failed\n"); return; }
    Params p{};
    for (int i = 0; i < 34; ++i) p.in[i] = (const float*)d_in[i];
    p.out = (float*)d_out; p.ws = (unsigned char*)d_ws;
#if MK_LAUNCH_PER_PHASE
    for (int ph = 0; ph < PH_LIMIT; ++ph) { p.ph_lo = ph; p.ph_hi = ph + 1; hipLaunchKernelGGL(hybrid_fwd, dim3(grid), dim3(512), LDS_BYTES, stream, p); }
#else
    p.ph_lo = 0; p.ph_hi = N_PHASES;
    void* args[] = {&p};
    hipError_t e = hipLaunchCooperativeKernel((const void*)hybrid_fwd, dim3(grid), dim3(512), args, LDS_BYTES, stream);
    if (e != hipSuccess) fprintf(stderr, "cooperative launch failed: %s (grid %d)\n", hipGetErrorString(e), grid);
#endif
}
```

```cpp
#include <hip/hip_runtime.h>
#include <hip/hip_cooperative_groups.h>
#include <cstdio>
#include <cstdint>
namespace cg = cooperative_groups;


#ifndef MK_LAUNCH_PER_PHASE
#define MK_LAUNCH_PER_PHASE 0
#endif

#define LAS __attribute__((address_space(3)))
typedef unsigned short bf16_t;
typedef short bf16x8 __attribute__((ext_vector_type(8)));
typedef float f32x4 __attribute__((ext_vector_type(4)));
typedef float f32x16 __attribute__((ext_vector_type(16)));
typedef unsigned u32x4 __attribute__((ext_vector_type(4)));
typedef unsigned u32x2 __attribute__((ext_vector_type(2)));

constexpr int D = 1024, NPB = 4, SEQ = 4096, DEPTH = 4, NSB = 128, SSEQ = 4;
constexpr int MP = NPB * SEQ;
constexpr int MS = NSB * SSEQ;
constexpr int M = MP + MS;
constexpr int NIN = 1536, DFF = 2816, NGU = 2 * DFF;
constexpr int NMODROWS = NPB + NSB;
constexpr int CT = 16;
constexpr int NCHUNK = MP / CT;
constexpr int KY = 384;
constexpr float EPS = 1e-6f;

constexpr size_t MiB = 1u << 20;
constexpr size_t WS_ROPE = 1 * MiB, WS_SC = 3 * MiB, WS_APOW = 4 * MiB, WS_BB = 5 * MiB, WS_MOD = 8 * MiB;
constexpr size_t WS_WGLU = 22 * MiB, WS_BTE = 23 * MiB, WS_BTY = 28 * MiB, WS_WIN = 40 * MiB, WS_WOUT = 52 * MiB;
constexpr size_t WS_WGU = 60 * MiB, WS_WDN = 104 * MiB, WS_X = 126 * MiB, WS_XN = 192 * MiB, WS_H = 225 * MiB;
constexpr size_t WS_MIX = 225 * MiB, WS_Q = 258 * MiB, WS_K = 275 * MiB, WS_V = 280 * MiB, WS_ZUT = 285 * MiB;
constexpr size_t WS_VC = 297 * MiB, WS_Z = 306 * MiB, WS_ZUS = 315 * MiB, WS_WMOD = 225 * MiB, WS_PART = 316 * MiB, WS_END = 362 * MiB;

constexpr size_t O_YP = 0, O_YS = O_YP + (size_t)MP * D, O_KP = O_YS + (size_t)MS * D, O_VP = O_KP + 262144, O_RP = O_VP + 262144;
constexpr size_t O_IP = O_RP + 16384, O_CP = O_IP + 16384, O_KS = O_CP + 122880, O_VS = O_KS + 8388608, O_RS = O_VS + 8388608;
constexpr size_t O_IS = O_RS + 524288, O_CS = O_IS + 524288, O_END = O_CS + 3932160;

constexpr int LDS_BYTES = 147456;

typedef float f32x2_t __attribute__((ext_vector_type(2))); typedef __bf16 bf16x2_t __attribute__((ext_vector_type(2)));
__device__ __forceinline__ unsigned cvt_pk_bf16(float lo, float hi) { const f32x2_t v = {lo, hi}; const bf16x2_t b = __builtin_convertvector(v, bf16x2_t); return __builtin_bit_cast(unsigned, b); }
__device__ __forceinline__ float bf2f(unsigned h) { return __builtin_bit_cast(float, h << 16); }
__device__ __forceinline__ float bflo(unsigned w) { return __builtin_bit_cast(float, w << 16); }
__device__ __forceinline__ float bfhi(unsigned w) { return __builtin_bit_cast(float, w & 0xffff0000u); }
__device__ __forceinline__ bf16_t f2bf(float f) { return (bf16_t)(cvt_pk_bf16(f, 0.f) & 0xffffu); }
__device__ __forceinline__ float sigmoidf_(float x) { return __builtin_amdgcn_rcpf(1.0f + __expf(-x)); }
__device__ __forceinline__ float gelu_tanh(float y) { const float u = 0.7978845608028654f * (y + 0.044715f * y * y * y); return y * (1.0f - __builtin_amdgcn_rcpf(1.0f + __expf(2.0f * u))); }
__device__ __forceinline__ void cis_rev(double ang, float& c, float& s) { double rev = ang * 0.15915494309189535; rev -= rint(rev); const float x = (float)(rev * 6.283185307179586); s = sinf(x); c = cosf(x); }
__device__ __forceinline__ float swz_f(float v, int pat) { return 0.f; }
#define SWZ(v, pat) __builtin_bit_cast(float, __builtin_amdgcn_ds_swizzle(__builtin_bit_cast(int, (v)), (pat)))
__device__ __forceinline__ float xor32_sum(float v) { float a = v, b = v; asm volatile("s_nop 1\n\tv_permlane32_swap_b32 %0, %1\n\ts_nop 1" : "+v"(a), "+v"(b)); return a + b; }
__device__ __forceinline__ float xor32_max(float v) { float a = v, b = v; asm volatile("s_nop 1\n\tv_permlane32_swap_b32 %0, %1\n\ts_nop 1" : "+v"(a), "+v"(b)); return fmaxf(a, b); }
__device__ __forceinline__ float wave_sum(float v) {
    v += SWZ(v, 0x041f); v += SWZ(v, 0x081f); v += SWZ(v, 0x101f); v += SWZ(v, 0x201f); v += SWZ(v, 0x401f); return xor32_sum(v);
}
__device__ __forceinline__ float wave_max(float v) {
    v = fmaxf(v, SWZ(v, 0x041f)); v = fmaxf(v, SWZ(v, 0x081f)); v = fmaxf(v, SWZ(v, 0x101f)); v = fmaxf(v, SWZ(v, 0x201f)); v = fmaxf(v, SWZ(v, 0x401f)); return xor32_max(v);
}

namespace pg8 {
constexpr int BM = 256, BK = 64, HALF = 128, HTB = HALF * BK * 2, STAGE_BYTES = 8 * HTB, NXCD = 8, WGM = 8;
__host__ __device__ __forceinline__ int lds_byte(int r, int c) { const int st = (r >> 4) * 2 + (c >> 5), rr = r & 15, cc = c & 31, ob = rr * 64 + cc * 2; return st * 1024 + (ob ^ (((ob >> 9) & 1) << 5)); }
__host__ __device__ __forceinline__ void stage_rc(int b, int& R, int& C) { const int st = b / 1024, sb = b % 1024, swz = sb ^ (((sb >> 9) & 1) << 5); R = (st >> 1) * 16 + swz / 64; C = (st & 1) * 32 + (swz % 64) / 2; }

__host__ __device__ __forceinline__ int perm32(int rho) { const int n = rho >> 4, i = rho & 15; return 8 * (i >> 2) + 4 * n + (i & 3); }
struct Unit { int pm, pn, z, k0, nt, split; };
struct Gemm { const bf16_t* A; const bf16_t* Bt; int K, lda, ldb; size_t sAz, sBz; };

struct Order {
    int nM, nN, nwg, tot, G, c, ntK, nsplit, nMfull;
    __device__ void init(int nM_, int nN_, int nZ_, int G_, int c_, int ntK_) { nM = nM_; nN = nN_; nwg = nM_ * nN_; tot = nwg * nZ_; G = G_; c = c_; ntK = ntK_; nsplit = 0; nMfull = nM_; }
    __device__ void init_split(int nMfull_, int nMtail, int nN_, int G_, int c_, int ntK_) { nM = nMfull_; nN = nN_; nwg = nMfull_ * nN_; nsplit = ntK_ / 4; tot = nwg + nMtail * nN_ * nsplit; G = G_; c = c_; ntK = ntK_; nMfull = nMfull_; }
    __device__ bool next(int i, Unit& u) const {
        const long L = (long)i * G + c; if (c < 0 || L >= tot) return false;
        if (nsplit > 0 && L >= nwg) { const int r = (int)L - nwg, su = r / nsplit, sp = r % nsplit; u.pm = nMfull + su / nN; u.pn = su % nN; u.z = 0; u.k0 = sp * 256; u.nt = 4; u.split = 1; return true; }
        const int z = (int)(L / nwg); int wgid = (int)(L % nwg);
        { const int q = nwg / NXCD, r = nwg % NXCD, xcd = wgid % NXCD, off = wgid / NXCD; wgid = (xcd < r ? xcd * (q + 1) : r * (q + 1) + (xcd - r) * q) + off; }
        const int nig = WGM * nN, gid = wgid / nig, fm = gid * WGM, gsz = (nM - fm) < WGM ? (nM - fm) : WGM;
        u.pm = fm + ((wgid % nig) % gsz); u.pn = (wgid % nig) / gsz; u.z = z; u.k0 = 0; u.nt = ntK; u.split = 0; return true;
    }
};

template <class Epi, bool ALIGN_EPI>
__device__ __forceinline__ void gemm_phase(LAS unsigned char* lds, const Gemm g, const Order& S, const Epi& E, const int wave_id) {
    int lane; asm volatile("v_mbcnt_lo_u32_b32 %0, -1, 0\n\tv_mbcnt_hi_u32_b32 %0, -1, %0" : "=v"(lane));
    int wid = wave_id; asm volatile("" : "+s"(wid)); const int tid = wid * 64 + lane, wr = wid >> 2, wc = wid & 3, fr = lane & 15, fq = lane >> 4;
    unsigned voffA[2], voffB[2];
#pragma unroll
    for (int i = 0; i < 2; ++i) { int R, C; stage_rc(tid * 16 + i * 8192, R, C); const int Rb = Epi::PERM ? ((R & ~31) + perm32(R & 31)) : R; voffA[i] = (unsigned)(R * g.lda + C) * 2u; voffB[i] = (unsigned)(Rb * g.ldb + C) * 2u; }
    const size_t kstep = (size_t)(BK * 2);
    const size_t hstepA = (size_t)HALF * g.lda * 2, hstepB = (size_t)HALF * g.ldb * 2;
    const unsigned ldsw = (unsigned)wid * 1024u;
    const int aoff = lds_byte(wr * 64 + fr, fq * 8), boff = lds_byte(wc * 32 + fr, fq * 8);
#define PG8_SA(b, h) (((b) * 2 + (h)) * HTB)
#define PG8_SB(b, h) ((4 + (b) * 2 + (h)) * HTB)
#define PG8_STAGE(bufoff, gbase, voff) do { _Pragma("unroll") for (int _i = 0; _i < 2; ++_i) \
        __builtin_amdgcn_global_load_lds((const unsigned*)((const char*)(gbase) + (voff)[_i]), (LAS unsigned*)(lds + (bufoff) + ldsw + _i * 8192), 16, 0, 0); } while (0)
#define PG8_LDA(dst, b, h) do { _Pragma("unroll") for (int m = 0; m < 4; ++m) _Pragma("unroll") for (int k = 0; k < 2; ++k) dst[m][k] = *(const LAS bf16x8*)(lds + PG8_SA(b, h) + aoff + m * 2048 + k * 1024); } while (0)
#define PG8_LDB(dst, b, h) do { _Pragma("unroll") for (int n = 0; n < 2; ++n) _Pragma("unroll") for (int k = 0; k < 2; ++k) dst[n][k] = *(const LAS bf16x8*)(lds + PG8_SB(b, h) + boff + n * 2048 + k * 1024); } while (0)
#define PG8_MMA(ai, bj, At, Bt) do { __builtin_amdgcn_s_setprio(1); _Pragma("unroll") for (int m = 0; m < 4; ++m) _Pragma("unroll") for (int n = 0; n < 2; ++n) _Pragma("unroll") for (int k = 0; k < 2; ++k) \
        acc[ai][bj][m][n] = __builtin_amdgcn_mfma_f32_16x16x32_bf16(Bt[n][k], At[m][k], acc[ai][bj][m][n], 0, 0, 0); __builtin_amdgcn_s_setprio(0); } while (0)
#define PG8_WAIT_V(n) asm volatile("s_waitcnt vmcnt(" #n ")" ::: "memory")
#define PG8_WAIT_L(n) asm volatile("s_waitcnt lgkmcnt(" #n ")" ::: "memory")
#define PG8_BAR __builtin_amdgcn_s_barrier()
#define PG8_SCHED __builtin_amdgcn_sched_barrier(0)
    Unit cur, nxt; int ui = 0;
    if (!S.next(0, cur)) return;
    f32x4 acc[2][2][4][2];
#pragma unroll
    for (int a = 0; a < 2; ++a)
#pragma unroll
        for (int b = 0; b < 2; ++b)
#pragma unroll
            for (int m = 0; m < 4; ++m)
#pragma unroll
                for (int n = 0; n < 2; ++n) acc[a][b][m][n] = (f32x4){0.f, 0.f, 0.f, 0.f};
    bf16x8 At[4][2], B0[2][2], B1[2][2];
    const char* cA = (const char*)g.A + (size_t)cur.z * g.sAz + (size_t)cur.pm * 2 * hstepA + (size_t)cur.k0 * 2; const char* cB = (const char*)g.Bt + (size_t)cur.z * g.sBz + (size_t)cur.pn * 2 * hstepB + (size_t)cur.k0 * 2;
    PG8_STAGE(PG8_SB(0, 0), cB, voffB); PG8_STAGE(PG8_SB(0, 1), cB + hstepB, voffB); PG8_STAGE(PG8_SA(0, 0), cA, voffA); PG8_STAGE(PG8_SA(0, 1), cA + hstepA, voffA);
    if (wr == 1) PG8_BAR;
    PG8_WAIT_V(2); PG8_BAR;
    PG8_STAGE(PG8_SB(1, 0), cB + kstep, voffB); PG8_STAGE(PG8_SA(1, 0), cA + kstep, voffA); PG8_STAGE(PG8_SB(1, 1), cB + hstepB + kstep, voffB);
    PG8_WAIT_V(6); PG8_BAR;
    for (;;) {
        const bool has_next = S.next(ui + 1, nxt);
        const char* nA = has_next ? (const char*)g.A + (size_t)nxt.z * g.sAz + (size_t)nxt.pm * 2 * hstepA + (size_t)nxt.k0 * 2 : cA;
        const char* nB = has_next ? (const char*)g.Bt + (size_t)nxt.z * g.sBz + (size_t)nxt.pn * 2 * hstepB + (size_t)nxt.k0 * 2 : cB;
        const int nt = cur.nt;
        for (int t = 0; t < nt; t += 2) {
            const bool last = (t == nt - 2);
            const char* a1 = cA + (size_t)(t + 1) * kstep;
            const char* a2 = last ? nA : cA + (size_t)(t + 2) * kstep; const char* b2 = last ? nB : cB + (size_t)(t + 2) * kstep;
            const char* a3 = a2 + kstep; const char* b3 = b2 + kstep;
            PG8_LDB(B0, 0, 0); PG8_LDB(B1, 0, 1); PG8_SCHED; PG8_LDA(At, 0, 0); PG8_STAGE(PG8_SA(1, 1), a1 + hstepA, voffA);
            PG8_WAIT_V(8); PG8_WAIT_L(0); PG8_BAR; PG8_MMA(0, 0, At, B0); PG8_MMA(0, 1, At, B1); PG8_BAR; PG8_SCHED;
            PG8_LDA(At, 0, 1); PG8_STAGE(PG8_SB(0, 0), b2, voffB); PG8_STAGE(PG8_SB(0, 1), b2 + hstepB, voffB); PG8_STAGE(PG8_SA(0, 0), a2, voffA);
            PG8_WAIT_V(8); PG8_WAIT_L(0); PG8_BAR; PG8_MMA(1, 0, At, B0); PG8_MMA(1, 1, At, B1); PG8_BAR; PG8_SCHED;
            PG8_LDB(B0, 1, 0); PG8_LDB(B1, 1, 1); PG8_SCHED; PG8_LDA(At, 1, 0); PG8_STAGE(PG8_SA(0, 1), a2 + hstepA, voffA);
            PG8_WAIT_V(8); PG8_WAIT_L(0); PG8_BAR; PG8_MMA(0, 0, At, B0); PG8_MMA(0, 1, At, B1); PG8_BAR; PG8_SCHED;
            PG8_LDA(At, 1, 1); PG8_STAGE(PG8_SB(1, 0), b3, voffB); PG8_STAGE(PG8_SB(1, 1), b3 + hstepB, voffB); PG8_STAGE(PG8_SA(1, 0), a3, voffA);
            PG8_WAIT_V(8); PG8_WAIT_L(0); PG8_BAR; PG8_MMA(1, 0, At, B0); PG8_MMA(1, 1, At, B1); PG8_BAR; PG8_SCHED;
        }
        if constexpr (ALIGN_EPI) { if (wr == 0) PG8_BAR; }
        if constexpr (!Epi::AFTER_DRAIN) { int fr_e = fr, fq_e = fq; asm volatile("" : "+v"(fr_e), "+v"(fq_e)); E(acc, cur, wr, wc, fr_e, fq_e); }
        if (!has_next) break;
#pragma unroll
        for (int a = 0; a < 2; ++a)
#pragma unroll
            for (int b = 0; b < 2; ++b)
#pragma unroll
                for (int m = 0; m < 4; ++m)
#pragma unroll
                    for (int n = 0; n < 2; ++n) acc[a][b][m][n] = (f32x4){0.f, 0.f, 0.f, 0.f};
        cur = nxt; cA = nA; cB = nB; ++ui;
        if constexpr (ALIGN_EPI) { if (wr == 1) PG8_BAR; }
    }
    PG8_WAIT_V(0);
    if constexpr (!ALIGN_EPI) { if (wr == 0) PG8_BAR; }
    PG8_BAR;
    if constexpr (Epi::AFTER_DRAIN) { E.fused(acc, cur, wr, wc, fr, fq, lds, wid, lane); }
#undef PG8_SA
#undef PG8_SB
#undef PG8_STAGE
#undef PG8_LDA
#undef PG8_LDB
#undef PG8_MMA
#undef PG8_WAIT_V
#undef PG8_WAIT_L
#undef PG8_BAR
#undef PG8_SCHED
}
}
using pg8::Unit;
typedef f32x4 Acc[2][2][4][2];

__device__ __forceinline__ int mod_row(int row) { return row < MP ? (row >> 12) : NPB + ((row - MP) >> 2); }

struct EpiMod {
    static constexpr bool AFTER_DRAIN = false, PERM = false;
    float* mod; const float* bmod;
    __device__ __forceinline__ void operator()(const Acc& acc, const Unit& u, int wr, int wc, int fr, int fq) const {
#pragma unroll
        for (int ai = 0; ai < 2; ++ai)
#pragma unroll
            for (int m = 0; m < 4; ++m) { const int row = ai * 128 + wr * 64 + m * 16 + fr;
                if (row < NMODROWS) {
#pragma unroll
                    for (int bj = 0; bj < 2; ++bj)
#pragma unroll
                        for (int n = 0; n < 2; ++n) { const int col = u.pn * 256 + bj * 128 + wc * 32 + n * 16 + fq * 4;
                            const f32x4 b = *(const f32x4*)(bmod + (size_t)u.z * 6144 + col);
                            *(f32x4*)(mod + ((size_t)u.z * NMODROWS + row) * 6144 + col) = acc[ai][bj][m][n] + b; } } }
    }
};

struct EpiIn {
    static constexpr bool AFTER_DRAIN = false, PERM = false;
    bf16_t *Q, *Kb, *Vb, *ZUT, *VC; float* ZUS; const float* rope;
    float* out; int l;
    __device__ __forceinline__ void operator()(const Acc& acc, const Unit& u, int wr, int wc, int fr, int fq) const {
#pragma unroll
        for (int ai = 0; ai < 2; ++ai)
#pragma unroll
            for (int m = 0; m < 4; ++m) {
                const int row = u.pm * 256 + ai * 128 + wr * 64 + m * 16 + fr;
                const bool samp = row >= MP; const int rs = row - MP;
                const int b = samp ? (rs >> 2) : (row >> 12), t = samp ? (rs & 3) : (row & 4095);
                const float* rp = rope + (size_t)(samp ? 4096 + t : t) * 64;
                if (u.pn <= 1) {
#pragma unroll
                    for (int n = 0; n < 2; ++n) { const int d = n * 16 + fq * 4;
                        const f32x4 cs = *(const f32x4*)(rp + d), sn = *(const f32x4*)(rp + 32 + d);
                        const f32x4 x1 = acc[ai][0][m][n], x2 = acc[ai][1][m][n];
                        const f32x4 o1 = (x1 * cs - x2 * sn) * 0.125f, o2 = (x2 * cs + x1 * sn) * 0.125f;
                        bf16_t* qp = Q + (size_t)row * 512 + (u.pn * 4 + wc) * 64 + d;
                        *(u32x2*)qp = (u32x2){cvt_pk_bf16(o1[0], o1[1]), cvt_pk_bf16(o1[2], o1[3])};
                        *(u32x2*)(qp + 32) = (u32x2){cvt_pk_bf16(o2[0], o2[1]), cvt_pk_bf16(o2[2], o2[3])}; }
                } else if (u.pn == 2) {
                    const bool keep = samp || t >= SEQ - 128;
                    const size_t orow = samp ? ((size_t)b * 128 + 124 + t) : ((size_t)b * 128 + (t - (SEQ - 128)));
                    const size_t okoff = samp ? (O_KS + (size_t)l * 2097152) : (O_KP + (size_t)l * 65536), ovoff = samp ? (O_VS + (size_t)l * 2097152) : (O_VP + (size_t)l * 65536);
                    if (wc < 2) {
#pragma unroll
                        for (int n = 0; n < 2; ++n) { const int d = n * 16 + fq * 4;
                            const f32x4 cs = *(const f32x4*)(rp + d), sn = *(const f32x4*)(rp + 32 + d);
                            const f32x4 x1 = acc[ai][0][m][n], x2 = acc[ai][1][m][n];
                            const f32x4 o1 = x1 * cs - x2 * sn, o2 = x2 * cs + x1 * sn;
                            bf16_t* kp = Kb + (size_t)row * 128 + wc * 64 + d;
                            *(u32x2*)kp = (u32x2){cvt_pk_bf16(o1[0], o1[1]), cvt_pk_bf16(o1[2], o1[3])};
                            *(u32x2*)(kp + 32) = (u32x2){cvt_pk_bf16(o2[0], o2[1]), cvt_pk_bf16(o2[2], o2[3])};
                            if (keep) { float* op = out + okoff + (orow * 2 + wc) * 64 + d; *(f32x4*)op = o1; *(f32x4*)(op + 32) = o2; } }
                    } else {
#pragma unroll
                        for (int bj = 0; bj < 2; ++bj)
#pragma unroll
                            for (int n = 0; n < 2; ++n) { const int d = (wc - 2) * 32 + n * 16 + fq * 4; const f32x4 v = acc[ai][bj][m][n];
                                *(u32x2*)(Vb + (size_t)row * 128 + bj * 64 + d) = (u32x2){cvt_pk_bf16(v[0], v[1]), cvt_pk_bf16(v[2], v[3])};
                                if (keep) *(f32x4*)(out + ovoff + (orow * 2 + bj) * 64 + d) = v; }
                    }
                } else if (u.pn == 3) {
#pragma unroll
                    for (int bj = 0; bj < 2; ++bj)
#pragma unroll
                        for (int n = 0; n < 2; ++n) { const int col = bj * 128 + wc * 32 + n * 16 + fq * 4; const f32x4 v = acc[ai][bj][m][n];
                            if (samp) *(f32x4*)(ZUS + (size_t)rs * 256 + col) = v;
                            else *(u32x2*)(ZUT + ((size_t)(col >> 4) * NCHUNK + (row >> 4)) * KY + (row & 15) * 16 + (col & 15)) = (u32x2){cvt_pk_bf16(v[0], v[1]), cvt_pk_bf16(v[2], v[3])}; }
                } else {
                    const bool keep = samp || t >= SEQ - 30;
                    const size_t orow = samp ? ((size_t)b * 30 + 26 + t) : ((size_t)b * 30 + (t - (SEQ - 30)));
                    const size_t ocoff = samp ? (O_CS + (size_t)l * 983040) : (O_CP + (size_t)l * 30720);
#pragma unroll
                    for (int n = 0; n < 2; ++n) { const int ch = (u.pn - 4) * 128 + wc * 32 + n * 16 + fq * 4;
                        const f32x4 za = acc[ai][0][m][n], zg = acc[ai][1][m][n]; f32x4 v;
#pragma unroll
                        for (int i = 0; i < 4; ++i) v[i] = za[i] * sigmoidf_(zg[i]);
                        *(u32x2*)(VC + (size_t)row * 256 + ch) = (u32x2){cvt_pk_bf16(v[0], v[1]), cvt_pk_bf16(v[2], v[3])};
                        if (keep) *(f32x4*)(out + ocoff + orow * 256 + ch) = v; }
                }
            }
    }
};

struct EpiE {
    static constexpr bool AFTER_DRAIN = true, PERM = false;
    bf16_t* ZUT; const float* apow;
    float *ore, *oim;
    __device__ __forceinline__ void fused(const Acc& acc, const Unit& u, int wr, int wc, int fr, int fq, LAS unsigned char* lds, int wid, int lane) const {
        LAS float* Es = (LAS float*)lds;
#pragma unroll
        for (int ai = 0; ai < 2; ++ai)
#pragma unroll
            for (int m = 0; m < 4; ++m)
#pragma unroll
                for (int n = 0; n < 2; ++n) { const int r = ai * 128 + wr * 64 + m * 16 + fr, c = wc * 32 + n * 16 + fq * 4; *(LAS f32x4*)(Es + r * 128 + c) = acc[ai][0][m][n]; }
        __syncthreads();
        if (wid == 0) {
            const int g = u.z, b = u.pm, p = lane;
            const float ar = apow[((g * 17 + 16) * 64 + p) * 2], aim = apow[((g * 17 + 16) * 64 + p) * 2 + 1];
            float hr = 0.f, hi = 0.f;
            bf16_t* zp = ZUT + ((size_t)g * NCHUNK + (size_t)b * 256) * KY + 256 + p;
            float er = Es[p], ei = Es[64 + p];
            for (int j = 0; j < 256; ++j) {
                zp[(size_t)j * KY] = f2bf(hr); zp[(size_t)j * KY + 64] = f2bf(hi);
                const int jn = j < 255 ? j + 1 : 255; const float ern = Es[jn * 128 + p], ein = Es[jn * 128 + 64 + p];
                const float nr = ar * hr - aim * hi + er, ni = ar * hi + aim * hr + ei; hr = nr; hi = ni; er = ern; ei = ein;
            }
            ore[(b * 16 + g) * 64 + p] = hr; oim[(b * 16 + g) * 64 + p] = hi;
        }
        __syncthreads();
    }
};

struct EpiY {
    static constexpr bool AFTER_DRAIN = false, PERM = false;
    bf16_t* Z;
    __device__ __forceinline__ void operator()(const Acc& acc, const Unit& u, int wr, int wc, int fr, int fq) const {
#pragma unroll
        for (int ai = 0; ai < 2; ++ai)
#pragma unroll
            for (int m = 0; m < 4; ++m) { const int crow = u.pm * 256 + ai * 128 + wr * 64 + m * 16 + fr;
#pragma unroll
                for (int bj = 0; bj < 2; ++bj)
#pragma unroll
                    for (int n = 0; n < 2; ++n) { const int col = bj * 128 + wc * 32 + n * 16 + fq * 4, t = col >> 4, cp = col & 15; const f32x4 v = acc[ai][bj][m][n];
                        *(u32x2*)(Z + ((size_t)crow * 16 + t) * 256 + u.z * 16 + cp) = (u32x2){cvt_pk_bf16(gelu_tanh(v[0]), gelu_tanh(v[1])), cvt_pk_bf16(gelu_tanh(v[2]), gelu_tanh(v[3]))}; } }
    }
};

struct EpiGlu {
    static constexpr bool AFTER_DRAIN = false, PERM = false;
    const bf16_t* Z; bf16_t* MIX; const float* bglu;
    __device__ __forceinline__ void operator()(const Acc& acc, const Unit& u, int wr, int wc, int fr, int fq) const {
#pragma unroll
        for (int ai = 0; ai < 2; ++ai)
#pragma unroll
            for (int m = 0; m < 4; ++m) { const int row = u.pm * 256 + ai * 128 + wr * 64 + m * 16 + fr;
#pragma unroll
                for (int bj = 0; bj < 2; ++bj)
#pragma unroll
                    for (int n = 0; n < 2; ++n) { const int col = bj * 128 + wc * 32 + n * 16 + fq * 4; const f32x4 a = acc[ai][bj][m][n] + *(const f32x4*)(bglu + col);
                        const u32x2 zw = *(const u32x2*)(Z + (size_t)row * 256 + col);
                        const float o0 = bflo(zw.x) * sigmoidf_(a[0]), o1 = bfhi(zw.x) * sigmoidf_(a[1]), o2 = bflo(zw.y) * sigmoidf_(a[2]), o3 = bfhi(zw.y) * sigmoidf_(a[3]);
                        *(u32x2*)(MIX + (size_t)row * 1024 + 512 + col) = (u32x2){cvt_pk_bf16(o0, o1), cvt_pk_bf16(o2, o3)}; } }
    }
};

struct EpiRes {
    static constexpr bool AFTER_DRAIN = false, PERM = false;
    const float *xp, *xs;
    float* X; const float* gate; float* part;
    __device__ __forceinline__ void operator()(const Acc& acc, const Unit& u, int wr, int wc, int fr, int fq) const {
#pragma unroll
        for (int ai = 0; ai < 2; ++ai)
#pragma unroll
            for (int m = 0; m < 4; ++m) { const int row = u.pm * 256 + ai * 128 + wr * 64 + m * 16 + fr;
                const float* base = xp ? (row < MP ? xp + (size_t)row * D : xs + (size_t)(row - MP) * D) : X + (size_t)row * D;
                const float* gp = gate + (size_t)mod_row(row) * 6144;
#pragma unroll
                for (int bj = 0; bj < 2; ++bj)
#pragma unroll
                    for (int n = 0; n < 2; ++n) { const int col = u.pn * 256 + bj * 128 + wc * 32 + n * 16 + fq * 4;
                        const f32x4 ga = *(const f32x4*)(gp + col) * acc[ai][bj][m][n];
                        if (u.split) { *(f32x4*)(part + ((size_t)(u.k0 >> 8) * MS + (row - MP)) * D + col) = ga;
                        } else *(f32x4*)(X + (size_t)row * D + col) = *(const f32x4*)(base + col) + ga; } }
    }
};

struct EpiGU {
    static constexpr bool AFTER_DRAIN = false, PERM = true;
    bf16_t* H;
    __device__ __forceinline__ void operator()(const Acc& acc, const Unit& u, int wr, int wc, int fr, int fq) const {
#pragma unroll
        for (int ai = 0; ai < 2; ++ai)
#pragma unroll
            for (int m = 0; m < 4; ++m) { const int row = u.pm * 256 + ai * 128 + wr * 64 + m * 16 + fr;
                const int col = u.pn * 128 + wc * 32 + fq * 8; u32x4 w;
#pragma unroll
                for (int n = 0; n < 2; ++n) { const f32x4 g = acc[ai][0][m][n], up = acc[ai][1][m][n]; f32x4 h;
#pragma unroll
                    for (int i = 0; i < 4; ++i) h[i] = g[i] * sigmoidf_(g[i]) * up[i];
                    w[2 * n] = cvt_pk_bf16(h[0], h[1]); w[2 * n + 1] = cvt_pk_bf16(h[2], h[3]); }
                *(u32x4*)(H + (size_t)row * DFF + col) = w; }
    }
};

struct Params { const float* in[34]; float* out; unsigned char* ws; int ph_lo, ph_hi; };

__device__ __forceinline__ void transpose_item(const float* W, int K, int N, bf16_t* WT, int n0, int k0, int drow0, float* scr, int lane) {
    float wreg[32];
#pragma unroll
    for (int i = 0; i < 32; ++i) wreg[i] = W[(size_t)(k0 + 2 * i + (lane >> 5)) * N + n0 + (lane & 31)];
#pragma unroll
    for (int i = 0; i < 32; ++i) { const int kk = 2 * i + (lane >> 5); scr[kk * 33 + (lane & 31)] = wreg[i]; }
    asm volatile("s_waitcnt lgkmcnt(0)" ::: "memory");
    const int c = lane & 7;
#pragma unroll
    for (int j = 0; j < 4; ++j) { const int n = (lane >> 3) + 8 * j; const float* s = scr + (8 * c) * 33 + n;
        u32x4 o; o.x = cvt_pk_bf16(s[0 * 33], s[1 * 33]); o.y = cvt_pk_bf16(s[2 * 33], s[3 * 33]); o.z = cvt_pk_bf16(s[4 * 33], s[5 * 33]); o.w = cvt_pk_bf16(s[6 * 33], s[7 * 33]);
        *(u32x4*)(WT + (size_t)(drow0 + n) * K + k0 + 8 * c) = o; }
    asm volatile("s_waitcnt lgkmcnt(0)" ::: "memory");
}
__device__ __forceinline__ int win_dst_row(int c) {
    if (c < 512) { const int tile = c >> 8, cc = c & 255; return tile * 256 + 128 * ((cc & 63) >> 5) + 32 * (cc >> 6) + (cc & 31); }
    if (c < 640) { const int cc = c - 512; return 512 + 128 * ((cc & 63) >> 5) + 32 * (cc >> 6) + (cc & 31); }
    if (c < 768) { const int cc = c - 640; return 512 + 128 * (cc >> 6) + 64 + (cc & 63); }
    if (c < 1024) return c;
    if (c < 1280) { const int cc = c - 1024; return 1024 + 256 * (cc >> 7) + (cc & 127); }
    { const int cc = c - 1280; return 1024 + 256 * (cc >> 7) + 128 + (cc & 127); }
}

template <bool FINAL>
__device__ __forceinline__ void norm_rows(const float* xp, const float* xs, const float* X, const float* g, const float* sh, const float* sc, bf16_t* XN, float* out, int gw, int NGW, int lane, const float* part, int nsplit) {
    f32x4 vnext[4];
    if (gw < M) { const float* xr0 = xp ? (gw < MP ? xp + (size_t)gw * D : xs + (size_t)(gw - MP) * D) : X + (size_t)gw * D;
#pragma unroll
        for (int j = 0; j < 4; ++j) vnext[j] = *(const f32x4*)(xr0 + 4 * lane + 256 * j); }
    for (int row = gw; row < M; row += NGW) {
        f32x4 v[4]; float s = 0.f;
#pragma unroll
        for (int j = 0; j < 4; ++j) v[j] = vnext[j];
        { const int rn = row + NGW; if (rn < M) { const float* xrn = xp ? (rn < MP ? xp + (size_t)rn * D : xs + (size_t)(rn - MP) * D) : X + (size_t)rn * D;
#pragma unroll
            for (int j = 0; j < 4; ++j) vnext[j] = *(const f32x4*)(xrn + 4 * lane + 256 * j); } }
        if (nsplit > 0 && row >= MP) {
            for (int sp = 0; sp < nsplit; ++sp) { const float* pr = part + ((size_t)sp * MS + (row - MP)) * D + 4 * lane;
#pragma unroll
                for (int j = 0; j < 4; ++j) v[j] += *(const f32x4*)(pr + 256 * j); }
#pragma unroll
            for (int j = 0; j < 4; ++j) *(f32x4*)((float*)X + (size_t)row * D + 4 * lane + 256 * j) = v[j]; }
#pragma unroll
        for (int j = 0; j < 4; ++j) s += (v[j][0] * v[j][0] + v[j][1] * v[j][1]) + (v[j][2] * v[j][2] + v[j][3] * v[j][3]);
        const float rstd = 1.0f / sqrtf(wave_sum(s) * (1.0f / D) + EPS);
        const int mr = mod_row(row);
        if (!FINAL && xp && row >= MP) {
#pragma unroll
            for (int j = 0; j < 4; ++j) *(f32x4*)((float*)X + (size_t)row * D + 4 * lane + 256 * j) = v[j]; }
#pragma unroll
        for (int j = 0; j < 4; ++j) { const int col = 4 * lane + 256 * j; const f32x4 gg = *(const f32x4*)(g + col);
            if (FINAL) { *(f32x4*)(out + (size_t)row * D + col) = v[j] * rstd * gg; }
            else { const f32x4 s1 = *(const f32x4*)(sc + (size_t)mr * 6144 + col), s0 = *(const f32x4*)(sh + (size_t)mr * 6144 + col);
                const f32x4 h = v[j] * rstd * gg * (s1 + 1.0f) + s0;
                *(u32x2*)(XN + (size_t)row * D + col) = (u32x2){cvt_pk_bf16(h[0], h[1]), cvt_pk_bf16(h[2], h[3])}; } }
    }
}

constexpr int KS_PITCH = 144, VT_PITCH = 528, ATT_KS = 0, ATT_VT = 256 * KS_PITCH;
__device__ __forceinline__ void attn_prompt_unit(unsigned char* lds, const bf16_t* Q, const bf16_t* Kb, const bf16_t* Vb, bf16_t* MIX, const float* sinks, int unit, int tid) {
    const int kvh = unit & 1, nb = (unit >> 1) & 31, b = unit >> 6;
    const int wid = tid >> 6, lane = tid & 63;
    __syncthreads();
#pragma unroll
    for (int i = 0; i < 4; ++i) { const int ch = tid + 512 * i, kj = ch >> 3, c8 = ch & 7; const int tok = nb * 128 - 128 + kj;
        u32x4 kv = (u32x4){0u, 0u, 0u, 0u}, vv = kv;
        if (tok >= 0) { const size_t off = ((size_t)b * SEQ + tok) * 128 + kvh * 64 + c8 * 8; kv = *(const u32x4*)(Kb + off); vv = *(const u32x4*)(Vb + off); }
        *(u32x4*)(lds + ATT_KS + kj * KS_PITCH + c8 * 16) = kv;
        bf16_t* vt = (bf16_t*)(lds + ATT_VT) + kj;
#pragma unroll
        for (int j = 0; j < 4; ++j) { const unsigned w = vv[j]; vt[(size_t)(c8 * 8 + 2 * j) * (VT_PITCH / 2)] = (bf16_t)(w & 0xffffu); vt[(size_t)(c8 * 8 + 2 * j + 1) * (VT_PITCH / 2)] = (bf16_t)(w >> 16); } }
    __syncthreads();
    const int g = wid & 3, hh = wid >> 2, head = kvh * 4 + g, l32 = lane & 31, hi = lane >> 5;
    const float sink = sinks[head];
#pragma unroll 1
    for (int qs = 0; qs < 2; ++qs) {
        const int q0 = 64 * hh + 32 * qs, qi = q0 + l32;
        const size_t qrow = (size_t)b * SEQ + nb * 128 + qi;
        bf16x8 qf[4];
#pragma unroll
        for (int ks = 0; ks < 4; ++ks) qf[ks] = *(const bf16x8*)(Q + qrow * 512 + head * 64 + ks * 16 + hi * 8);
        f32x16 S[5];
#pragma unroll
        for (int kb = 0; kb < 5; ++kb) { f32x16 a = {0.f,0.f,0.f,0.f,0.f,0.f,0.f,0.f,0.f,0.f,0.f,0.f,0.f,0.f,0.f,0.f};
            const unsigned char* kp = lds + ATT_KS + (q0 + 32 * kb + l32) * KS_PITCH + hi * 16;
#pragma unroll
            for (int ks = 0; ks < 4; ++ks) { const bf16x8 kf = *(const bf16x8*)(kp + ks * 32); a = __builtin_amdgcn_mfma_f32_32x32x16_bf16(kf, qf[ks], a, 0, 0, 0); }
            S[kb] = a; }
        float mx = -1e30f;
#pragma unroll
        for (int kb = 0; kb < 5; ++kb)
#pragma unroll
            for (int r = 0; r < 16; ++r) { const int kj = q0 + 32 * kb + (r & 3) + 8 * (r >> 2) + 4 * hi; const int rel = 128 + qi - kj;
                const bool ok = (rel >= 0) && (rel < 128) && (nb > 0 || kj >= 128);
                const float s = ok ? S[kb][r] : -1e30f; S[kb][r] = s; mx = fmaxf(mx, s); }
        mx = fmaxf(xor32_max(mx), sink);
        float sum = 0.f;
#pragma unroll
        for (int kb = 0; kb < 5; ++kb)
#pragma unroll
            for (int r = 0; r < 16; ++r) { const float e = __expf(S[kb][r] - mx); S[kb][r] = e; sum += e; }
        sum = xor32_sum(sum) + __expf(sink - mx);
        const float inv = 1.0f / sum;
        bf16x8 P[5][2];
#pragma unroll
        for (int kb = 0; kb < 5; ++kb)
#pragma unroll
            for (int sl = 0; sl < 2; ++sl) { u32x4 w;
                w.x = cvt_pk_bf16(S[kb][8 * sl + 0] * inv, S[kb][8 * sl + 1] * inv); w.y = cvt_pk_bf16(S[kb][8 * sl + 2] * inv, S[kb][8 * sl + 3] * inv);
                w.z = cvt_pk_bf16(S[kb][8 * sl + 4] * inv, S[kb][8 * sl + 5] * inv); w.w = cvt_pk_bf16(S[kb][8 * sl + 6] * inv, S[kb][8 * sl + 7] * inv);
                P[kb][sl] = __builtin_bit_cast(bf16x8, w); }
#pragma unroll
        for (int db = 0; db < 2; ++db) { f32x16 o = {0.f,0.f,0.f,0.f,0.f,0.f,0.f,0.f,0.f,0.f,0.f,0.f,0.f,0.f,0.f,0.f};
            const unsigned char* vp = lds + ATT_VT + (32 * db + l32) * VT_PITCH + (q0 + 4 * hi) * 2;
#pragma unroll
            for (int kb = 0; kb < 5; ++kb)
#pragma unroll
                for (int sl = 0; sl < 2; ++sl) { const u32x2 lo = *(const u32x2*)(vp + (32 * kb + 16 * sl) * 2), hi2 = *(const u32x2*)(vp + (32 * kb + 16 * sl + 8) * 2);
                    const bf16x8 vf = __builtin_bit_cast(bf16x8, (u32x4){lo.x, lo.y, hi2.x, hi2.y});
                    o = __builtin_amdgcn_mfma_f32_32x32x16_bf16(vf, P[kb][sl], o, 0, 0, 0); }
            bf16_t* op = MIX + qrow * 1024 + head * 64 + 32 * db + 4 * hi;
#pragma unroll
            for (int r4 = 0; r4 < 4; ++r4) *(u32x2*)(op + 8 * r4) = (u32x2){cvt_pk_bf16(o[4 * r4], o[4 * r4 + 1]), cvt_pk_bf16(o[4 * r4 + 2], o[4 * r4 + 3])}; }
    }
}

__device__ __forceinline__ void attn_sample_wave(float* wl  , const bf16_t* Q, const bf16_t* Kb, const bf16_t* Vb, const float* ck, const float* cv, bf16_t* MIX, const float* sinks, int task, int lane) {
    const int g = task & 3, kvh = (task >> 2) & 1, b = task >> 3, head = kvh * 4 + g;
    float* qs = wl; float* ps = wl + 256;
#pragma unroll
    for (int t = 0; t < 4; ++t) qs[t * 64 + lane] = bf2f(Q[(size_t)(MP + b * 4 + t) * 512 + head * 64 + lane]);
    asm volatile("s_waitcnt lgkmcnt(0)" ::: "memory");
    float sc[3][4];
#pragma unroll
    for (int slot = 0; slot < 3; ++slot) {
        const int j = slot * 64 + lane; const bool have = (slot < 2) || (lane < 4);
        float d0 = 0.f, d1 = 0.f, d2 = 0.f, d3 = 0.f;
        if (have) {
            if (slot < 2) { const float* kr = ck + ((size_t)b * 128 + j) * 128 + kvh * 64;
#pragma unroll 8
                for (int d4 = 0; d4 < 16; ++d4) { const f32x4 kv = *(const f32x4*)(kr + 4 * d4);
#pragma unroll
                    for (int i = 0; i < 4; ++i) { const int d = 4 * d4 + i; d0 += kv[i] * qs[d]; d1 += kv[i] * qs[64 + d]; d2 += kv[i] * qs[128 + d]; d3 += kv[i] * qs[192 + d]; } }
            } else { const bf16_t* kr = Kb + (size_t)(MP + b * 4 + lane) * 128 + kvh * 64;
#pragma unroll 16
                for (int d = 0; d < 64; ++d) { const float kv = bf2f(kr[d]); d0 += kv * qs[d]; d1 += kv * qs[64 + d]; d2 += kv * qs[128 + d]; d3 += kv * qs[192 + d]; } }
        }
        const float dd[4] = {d0, d1, d2, d3};
#pragma unroll
        for (int t = 0; t < 4; ++t) { const bool ok = have && ((slot < 2) ? (j > t) : (lane <= t)); sc[slot][t] = ok ? dd[t] : -1e30f; }
    }
    const float sink = sinks[head];
#pragma unroll
    for (int t = 0; t < 4; ++t) {
        float mx = fmaxf(fmaxf(sc[0][t], sc[1][t]), sc[2][t]); mx = fmaxf(wave_max(mx), sink);
        const float e0 = __expf(sc[0][t] - mx), e1 = __expf(sc[1][t] - mx), e2 = __expf(sc[2][t] - mx);
        const float sum = wave_sum(e0 + e1 + e2) + __expf(sink - mx); const float inv = 1.0f / sum;
        ps[t * 132 + lane] = e0 * inv; ps[t * 132 + 64 + lane] = e1 * inv; if (lane < 4) ps[t * 132 + 128 + lane] = e2 * inv;
    }
    asm volatile("s_waitcnt lgkmcnt(0)" ::: "memory");
    float o0 = 0.f, o1 = 0.f, o2 = 0.f, o3 = 0.f;
    const float* vr = cv + (size_t)b * 128 * 128 + kvh * 64 + lane;
#pragma unroll 1
    for (int j0 = 0; j0 < 128; j0 += 32) { float vv[32];
#pragma unroll
        for (int jj = 0; jj < 32; ++jj) vv[jj] = vr[(size_t)(j0 + jj) * 128];
#pragma unroll
        for (int jj = 0; jj < 32; ++jj) { const int j = j0 + jj; const float v = vv[jj]; o0 += ps[j] * v; o1 += ps[132 + j] * v; o2 += ps[264 + j] * v; o3 += ps[396 + j] * v; } }
#pragma unroll
    for (int j = 0; j < 4; ++j) { const float v = bf2f(Vb[(size_t)(MP + b * 4 + j) * 128 + kvh * 64 + lane]); o0 += ps[128 + j] * v; o1 += ps[132 + 128 + j] * v; o2 += ps[264 + 128 + j] * v; o3 += ps[396 + 128 + j] * v; }
    bf16_t* op = MIX + (size_t)(MP + b * 4) * 1024 + head * 64 + lane;
    op[0] = f2bf(o0); op[1024] = f2bf(o1); op[2048] = f2bf(o2); op[3072] = f2bf(o3);
    asm volatile("s_waitcnt lgkmcnt(0)" ::: "memory");
}

__device__ __forceinline__ void conv_group(const bf16_t* VC, size_t vrow0  , int tvalid0  , const float* hist,
                                           const float* cw, const float* cb, const float* lg, const float* lb, bf16_t* MIX, size_t orow0, int lane) {
    const int c4 = lane * 4;
    u32x2 vr[34];
#pragma unroll
    for (int r = 0; r < 34; ++r) {
        if (hist && r < 30) { const f32x4 h = *(const f32x4*)(hist + (size_t)r * 256 + c4); vr[r] = (u32x2){cvt_pk_bf16(h[0], h[1]), cvt_pk_bf16(h[2], h[3])}; }
        else if (r < tvalid0) vr[r] = (u32x2){0u, 0u};
        else vr[r] = *(const u32x2*)(VC + (vrow0 + r - 30) * 256 + c4);
    }
    const f32x4 bias = *(const f32x4*)(cb + c4);
    f32x4 acc[4] = {bias, bias, bias, bias};
#pragma unroll
    for (int k = 0; k < 31; ++k) { const f32x4 w = *(const f32x4*)(cw + (size_t)k * 256 + c4);
#pragma unroll
        for (int jj = 0; jj < 4; ++jj) { const u32x2 v = vr[k + jj]; acc[jj] += w * (f32x4){bflo(v.x), bfhi(v.x), bflo(v.y), bfhi(v.y)}; } }
    const f32x4 gg = *(const f32x4*)(lg + c4), bb = *(const f32x4*)(lb + c4);
#pragma unroll
    for (int jj = 0; jj < 4; ++jj) { const f32x4 a = acc[jj];
        const float mean = wave_sum((a[0] + a[1]) + (a[2] + a[3])) * (1.0f / 256.0f);
        const f32x4 dl = a - mean; const float var = wave_sum((dl[0] * dl[0] + dl[1] * dl[1]) + (dl[2] * dl[2] + dl[3] * dl[3])) * (1.0f / 256.0f);
        const float rstd = 1.0f / sqrtf(var + EPS); f32x4 y = dl * rstd * gg + bb;
#pragma unroll
        for (int i = 0; i < 4; ++i) y[i] = y[i] * sigmoidf_(y[i]);
        *(u32x2*)(MIX + (orow0 + jj) * 1024 + 768 + c4) = (u32x2){cvt_pk_bf16(y[0], y[1]), cvt_pk_bf16(y[2], y[3])}; }
}

__device__ __forceinline__ void ssm_sample_wave(float* wl  , const float* ZUS, const float* sre, const float* sim, const float* apow, const float* bbt,
                                                const float* cre, const float* cim, const float* dsk, bf16_t* Z, float* ore, float* oim, int task, int lane) {
    const int g = task & 15, b = task >> 4, p = lane;
    const float ar = apow[((g * 17 + 1) * 64 + p) * 2], aim = apow[((g * 17 + 1) * 64 + p) * 2 + 1];
    float hr = sre[((size_t)b * 16 + g) * 64 + p], hi = sim[((size_t)b * 16 + g) * 64 + p];
    const float* bp = bbt + ((size_t)g * 64 + p) * 32;
    f32x4 bpv[8];
#pragma unroll
    for (int c4 = 0; c4 < 8; ++c4) bpv[c4] = *(const f32x4*)(bp + 4 * c4);
#pragma unroll
    for (int t = 0; t < 4; ++t) { const float* u = ZUS + (size_t)(b * 4 + t) * 256 + g * 16; float br = 0.f, bi = 0.f;
#pragma unroll
        for (int c4 = 0; c4 < 4; ++c4) { const f32x4 uv = *(const f32x4*)(u + 4 * c4);
#pragma unroll
            for (int i = 0; i < 4; ++i) { const int c = 4 * c4 + i; br += bpv[c >> 1][(c & 1) * 2] * uv[i]; bi += bpv[c >> 1][(c & 1) * 2 + 1] * uv[i]; } }
        const float nr = ar * hr - aim * hi + br, ni = ar * hi + aim * hr + bi; hr = nr; hi = ni;
        wl[t * 128 + p] = hr; wl[t * 128 + 64 + p] = hi; }
    ore[((size_t)b * 16 + g) * 64 + p] = hr; oim[((size_t)b * 16 + g) * 64 + p] = hi;
    asm volatile("s_waitcnt lgkmcnt(0)" ::: "memory");
    const int t = lane >> 4, cp = lane & 15;
    const float* cr = cre + ((size_t)g * 16 + cp) * 64; const float* ci = cim + ((size_t)g * 16 + cp) * 64;
    float y = 0.f;
    f32x4 crv[16], civ[16];
#pragma unroll
    for (int q4 = 0; q4 < 16; ++q4) { crv[q4] = *(const f32x4*)(cr + 4 * q4); civ[q4] = *(const f32x4*)(ci + 4 * q4); }
#pragma unroll
    for (int q4 = 0; q4 < 16; ++q4) { const f32x4 hr4 = *(const f32x4*)(wl + t * 128 + 4 * q4), hi4 = *(const f32x4*)(wl + t * 128 + 64 + 4 * q4);
#pragma unroll
        for (int i = 0; i < 4; ++i) y += crv[q4][i] * hr4[i] - civ[q4][i] * hi4[i]; }
    y += dsk[g * 16 + cp] * ZUS[(size_t)(b * 4 + t) * 256 + g * 16 + cp];
    Z[(size_t)(MP + b * 4 + t) * 256 + g * 16 + cp] = f2bf(gelu_tanh(y));
    asm volatile("s_waitcnt lgkmcnt(0)" ::: "memory");
}

__device__ __forceinline__ const void* ld_ptr(unsigned pb, int i) { const unsigned long long v = *(const LAS unsigned long long*)(pb + 8u * (unsigned)i);
    const unsigned lo = __builtin_amdgcn_readfirstlane((unsigned)v), hi = __builtin_amdgcn_readfirstlane((unsigned)(v >> 32));
    typedef __attribute__((address_space(1))) const void* gptr_t; return (const void*)(gptr_t)(((unsigned long long)hi << 32) | lo); }
constexpr int PTAB_OFF = 131072 + 1024;
#define XB_TMO      128
#define XB_XCNT(j)  (256  + 64 * (j))
#define XB_XSUB(j)  (1280 + 64 * (j))
#define XB_XGEN(j)  (2304 + 64 * (j))
#define XB_TOP      3328
#define XB_TOPGEN   3392
#define XCD_BAR_WORDS 3456
#define XB_SPIN_CAP (1u << 20)
__device__ __forceinline__ unsigned xb_ld(unsigned* p)              { return __hip_atomic_load(p, __ATOMIC_RELAXED, __HIP_MEMORY_SCOPE_AGENT); }
__device__ __forceinline__ unsigned xb_add(unsigned* p, unsigned v) { return __hip_atomic_fetch_add(p, v, __ATOMIC_RELAXED, __HIP_MEMORY_SCOPE_AGENT); }
__device__ __forceinline__ unsigned xb_xcc_id() { return (unsigned)__builtin_amdgcn_s_getreg((3 << 11) | 20) & 0xFu; }
#define XB_SPIN(cond, bar) do { unsigned _sp = 0; while (cond) { __builtin_amdgcn_s_sleep(1); \
    if ((++_sp & 255u) == 0u) { if (xb_ld(&(bar)[XB_TMO])) break; if (_sp > XB_SPIN_CAP) { atomicAdd(&(bar)[XB_TMO], 1u); break; } } } } while (0)
constexpr int XBST_OFF = PTAB_OFF + 512;
__device__ __forceinline__ void xcd_barrier_complete(unsigned* bar, unsigned x, unsigned G, unsigned& nloc, unsigned& nx) {
    unsigned sum, cnt, mine, sp = 0u;
    for (;;) {
        sum = 0u; cnt = 0u; mine = 0u;
#pragma unroll
        for (unsigned j = 0; j < 16; ++j) { const unsigned c = xb_ld(&bar[XB_XCNT(j)]); sum += c; cnt += (c > 0u) ? 1u : 0u; mine = (j == x) ? c : mine; }
        if (sum == G) break;
        __builtin_amdgcn_s_sleep(1);
        if ((++sp & 255u) == 0u) { if (xb_ld(&bar[XB_TMO])) break; if (sp > XB_SPIN_CAP) { atomicAdd(&bar[XB_TMO], 1u); break; } }
    }
    nloc = mine > 0u ? mine : 1u; nx = cnt > 0u ? cnt : 1u;
}
__device__ __forceinline__ void grid_barrier(unsigned* bar, unsigned G, int tid, volatile LAS unsigned* st) {
    asm volatile("s_waitcnt vmcnt(0) lgkmcnt(0)" ::: "memory");
    __syncthreads();
    if (tid == 0) {
        const unsigned x = xb_xcc_id();
        unsigned nloc = st[0], nx = st[1];
        if (nloc == 0u) { xcd_barrier_complete(bar, x, G, nloc, nx); st[0] = nloc; st[1] = nx; }
        const unsigned old = xb_add(&bar[XB_XSUB(x)], 1u);
        const unsigned gen = old / nloc;
        if (old + 1u == (gen + 1u) * nloc) {
            __builtin_amdgcn_fence(__ATOMIC_RELEASE, "agent");
            asm volatile("s_waitcnt vmcnt(0)" ::: "memory");
            const unsigned og = xb_add(&bar[XB_TOP], 1u);
            const unsigned tg = og / nx;
            if (og + 1u == (tg + 1u) * nx) xb_add(&bar[XB_TOPGEN], 1u);
            else XB_SPIN(xb_ld(&bar[XB_TOPGEN]) == tg, bar);
            __builtin_amdgcn_fence(__ATOMIC_ACQUIRE, "agent");
            xb_add(&bar[XB_XGEN(x)], 1u);
            asm volatile("s_waitcnt vmcnt(0)" ::: "memory");
        } else {
            XB_SPIN(xb_ld(&bar[XB_XGEN(x)]) == gen, bar);
            __builtin_amdgcn_fence(__ATOMIC_ACQUIRE, "agent");
            asm volatile("s_waitcnt vmcnt(0)" ::: "memory");
        }
    }
    __syncthreads();
}
__global__ void __launch_bounds__(512, 2) hybrid_fwd(Params P) {
    extern __shared__ __attribute__((aligned(16))) unsigned char lds[];
    LAS unsigned char* ldsl = (LAS unsigned char*)lds;
    const int G0 = gridDim.x, bid0 = blockIdx.x;
    const int wave0 = __builtin_amdgcn_readfirstlane((int)threadIdx.x >> 6);
#if !MK_LAUNCH_PER_PHASE
    cg::this_grid().sync();
#endif
    LAS unsigned long long* ptab = (LAS unsigned long long*)(ldsl + PTAB_OFF);
    if (threadIdx.x == 0) {
#pragma unroll
        for (int i = 0; i < 34; ++i) ptab[i] = (unsigned long long)P.in[i];
        ptab[34] = (unsigned long long)P.out; ptab[35] = (unsigned long long)P.ws;
        ((volatile LAS unsigned*)(ldsl + XBST_OFF))[0] = 0u; ((volatile LAS unsigned*)(ldsl + XBST_OFF))[1] = 0u;
        (void)xb_add((unsigned*)P.ws + XB_XCNT(xb_xcc_id()), 1u); }
    __syncthreads();
#define INP(i) ((const float*)ld_ptr(pb, (i)))
#define ROPE ((float*)(ws + WS_ROPE))
#define SC ((bf16_t*)(ws + WS_SC))
#define APOW ((float*)(ws + WS_APOW))
#define BB ((float*)(ws + WS_BB))
#define MOD ((float*)(ws + WS_MOD))
#define WGLU ((bf16_t*)(ws + WS_WGLU))
#define BTE ((bf16_t*)(ws + WS_BTE))
#define BTY ((bf16_t*)(ws + WS_BTY))
#define WIN ((bf16_t*)(ws + WS_WIN))
#define WOUT ((bf16_t*)(ws + WS_WOUT))
#define WGU ((bf16_t*)(ws + WS_WGU))
#define WDN ((bf16_t*)(ws + WS_WDN))
#define X ((float*)(ws + WS_X))
#define XN ((bf16_t*)(ws + WS_XN))
#define Hb ((bf16_t*)(ws + WS_H))
#define MIX ((bf16_t*)(ws + WS_MIX))
#define Qb ((bf16_t*)(ws + WS_Q))
#define Kb ((bf16_t*)(ws + WS_K))
#define Vb ((bf16_t*)(ws + WS_V))
#define ZUT ((bf16_t*)(ws + WS_ZUT))
#define VC ((bf16_t*)(ws + WS_VC))
#define Zb ((bf16_t*)(ws + WS_Z))
#define ZUS ((float*)(ws + WS_ZUS))
#define WMOD ((bf16_t*)(ws + WS_WMOD))
    const int lo = P.ph_lo, hi = P.ph_hi;
    int ph = 0;
#define PHASE_BEGIN if (ph >= lo && ph < hi) { int lane; asm volatile("v_mbcnt_lo_u32_b32 %0, -1, 0\n\tv_mbcnt_hi_u32_b32 %0, -1, %0" : "=v"(lane)); int G = G0, bid = bid0; asm volatile("" : "+s"(G), "+s"(bid)); const int NGW = G * 8, NGT = G * 512; (void)NGW; (void)NGT; int wave = wave0; asm volatile("" : "+s"(wave)); const int tid = wave * 64 + lane, gw = bid * 8 + wave, gt = bid * 512 + tid; (void)lane; (void)gw; (void)gt; \
    unsigned pb = (unsigned)(size_t)ptab; asm volatile("" : "+v"(pb)); unsigned char* const ws = (unsigned char*)ld_ptr(pb, 35); float* const out = (float*)ld_ptr(pb, 34); (void)out;
#if MK_LAUNCH_PER_PHASE
#define PHASE_END } ++ph;
#else
#define PHASE_END if (ph + 1 < hi) grid_barrier((unsigned*)ws, (unsigned)G, tid, (volatile LAS unsigned*)(ldsl + XBST_OFF)); } ++ph;
#endif

    PHASE_BEGIN
    {
        for (int i = gt; i < 4100 * 32; i += NGT) { const int idx = i >> 5, d = i & 31; const int pos = idx < 4096 ? idx : 8192 + (idx - 4096);
            const double invf = exp(-(double)d * (9.210340371976184 / 32.0)); float c, s; cis_rev((double)pos * invf, c, s); ROPE[idx * 64 + d] = c; ROPE[idx * 64 + 32 + d] = s; }
        { const float* cpr = INP(2); const float* csm = INP(3);
        for (int i = gt; i < 256 * 1024; i += NGT) { const int r = i >> 10, c = i & 1023; float v = 0.f;
            if (r < NPB) v = cpr[r * 1024 + c]; else if (r < NMODROWS) v = csm[(r - NPB) * 1024 + c];
            SC[i] = f2bf(v * sigmoidf_(v)); } }
        for (int i = gt; i < DEPTH * 16 * 17 * 64; i += NGT) { const int p = i & 63, k = (i >> 6) % 17, lg = i / (64 * 17);
            const float dt = __expf(INP(17)[lg]); const float lr = INP(15)[lg * 64 + p], li = INP(16)[lg * 64 + p];
            const float th = li * dt; float c, s; cis_rev((double)th * (double)k, c, s); const float mag = expf((float)k * (lr * dt));
            APOW[(size_t)i * 2] = mag * c; APOW[(size_t)i * 2 + 1] = mag * s; }
        for (int i = gt; i < DEPTH * 16 * 64 * 16; i += NGT) { const int c = i & 15, p = (i >> 4) & 63, lg = i >> 10;
            const float dt = __expf(INP(17)[lg]); const float lr = INP(15)[lg * 64 + p], li = INP(16)[lg * 64 + p];
            float cc, ss; cis_rev((double)(li * dt), cc, ss); const float mag = expf(lr * dt); const float abr = mag * cc, abi = mag * ss;
            const float den = lr * lr + li * li, nr = abr - 1.0f; const float cr = (nr * lr + abi * li) / den, ci = (abi * lr - nr * li) / den;
            const float br = INP(18)[(size_t)(lg * 64 + p) * 16 + c], bi = INP(19)[(size_t)(lg * 64 + p) * 16 + c];
            BB[(size_t)i * 2] = cr * br - ci * bi; BB[(size_t)i * 2 + 1] = cr * bi + ci * br; }
        { const float* ckp = INP(4); const float* cvp = INP(5); const float* scp = INP(8);
#pragma unroll 4
        for (int i = gt; i < DEPTH * NSB * 124 * 32; i += NGT) { const int c4 = i & 31, r = (i >> 5) % 124, lb = i / (32 * 124);
            const size_t src = ((size_t)lb * 128 + r + 4) * 128 + c4 * 4, dst = ((size_t)lb * 128 + r) * 128 + c4 * 4;
            *(f32x4*)(out + O_KS + dst) = *(const f32x4*)(ckp + src); *(f32x4*)(out + O_VS + dst) = *(const f32x4*)(cvp + src); }
#pragma unroll 4
        for (int i = gt; i < DEPTH * NSB * 26 * 64; i += NGT) { const int c4 = i & 63, r = (i >> 6) % 26, lb = i / (64 * 26);
            *(f32x4*)(out + O_CS + ((size_t)lb * 30 + r) * 256 + c4 * 4) = *(const f32x4*)(scp + ((size_t)lb * 30 + r + 4) * 256 + c4 * 4); } }
        float* scr = (float*)(lds + wave * 16384);
        constexpr int I_IN = 16 * 48, I_OUT = 16 * 32, I_G = 16 * 88, I_DN = 44 * 32, I_GLU = 4 * 8, I_MOD = 16 * 192;
        constexpr int I_LAYER = I_IN + I_OUT + 2 * I_G + I_DN + I_GLU + I_MOD;
        for (int it = gw; it < DEPTH * I_LAYER; it += NGW) {
            const int l = it / I_LAYER; int r = it % I_LAYER;
            if (r < I_IN) { const int kb = r / 48, nbk = r % 48; transpose_item(INP(13) + (size_t)l * D * NIN, D, NIN, WIN + (size_t)l * NIN * D, nbk * 32, kb * 64, win_dst_row(nbk * 32), scr, lane); continue; } r -= I_IN;
            if (r < I_OUT) { const int kb = r / 32, nbk = r % 32; transpose_item(INP(29) + (size_t)l * D * D, D, D, WOUT + (size_t)l * D * D, nbk * 32, kb * 64, nbk * 32, scr, lane); continue; } r -= I_OUT;
            if (r < I_G) { const int kb = r / 88, nbk = r % 88, n0 = nbk * 32; transpose_item(INP(30) + (size_t)l * D * DFF, D, DFF, WGU + (size_t)l * NGU * D, n0, kb * 64, 256 * (n0 >> 7) + (n0 & 127), scr, lane); continue; } r -= I_G;
            if (r < I_G) { const int kb = r / 88, nbk = r % 88, n0 = nbk * 32; transpose_item(INP(31) + (size_t)l * D * DFF, D, DFF, WGU + (size_t)l * NGU * D, n0, kb * 64, 256 * (n0 >> 7) + 128 + (n0 & 127), scr, lane); continue; } r -= I_G;
            if (r < I_DN) { const int kb = r / 32, nbk = r % 32; transpose_item(INP(32) + (size_t)l * DFF * D, DFF, D, WDN + (size_t)l * D * DFF, nbk * 32, kb * 64, nbk * 32, scr, lane); continue; } r -= I_DN;
            if (r < I_GLU) { const int kb = r / 8, nbk = r % 8; transpose_item(INP(23) + (size_t)l * 65536, 256, 256, WGLU + (size_t)l * 65536, nbk * 32, kb * 64, nbk * 32, scr, lane); continue; } r -= I_GLU;
            { const int kb = r / 192, nbk = r % 192; transpose_item(INP(11) + (size_t)l * D * 6144, D, 6144, WMOD + (size_t)l * 6144 * D, nbk * 32, kb * 64, nbk * 32, scr, lane); }
        }
    }
    PHASE_END

    PHASE_BEGIN
    {
        if (bid >= 96) {
        const int gt = (bid - 96) * 512 + tid, NGT = (G - 96) * 512;
        for (int i = gt; i < DEPTH * 16 * 31 * 256; i += NGT) { const int c = i & 15, cp = (i >> 4) & 15, ti = (i >> 8) % 31, lg = i / (256 * 31); const int tau = ti - 15;
            bf16_t* by = BTY + (size_t)lg * 256 * KY;
            if (tau < 0) { for (int t = 0; t <= 15 + tau; ++t) by[(size_t)(t * 16 + cp) * KY + (t - tau) * 16 + c] = 0; }
            else { const float* ap = APOW + ((size_t)lg * 17 + tau) * 128; const float* bp = BB + (size_t)lg * 64 * 32 + c * 2;
                const float* cr = INP(20) + ((size_t)lg * 16 + cp) * 64; const float* ci = INP(21) + ((size_t)lg * 16 + cp) * 64;
                float acc = 0.f;
                for (int p = 0; p < 64; ++p) { const float ar = ap[2 * p], ai = ap[2 * p + 1], br = bp[p * 32], bi = bp[p * 32 + 1];
                    const float wr_ = ar * br - ai * bi, wi_ = ar * bi + ai * br; acc += cr[p] * wr_ - ci[p] * wi_; }
                if (tau == 0 && c == cp) acc += INP(22)[lg * 16 + c];
                const bf16_t v = f2bf(acc);
                for (int t = tau; t < 16; ++t) by[(size_t)(t * 16 + cp) * KY + (t - tau) * 16 + c] = v; } }
        for (int i = gt; i < DEPTH * 16 * 16 * 16 * 64; i += NGT) { const int p = i & 63, cp = (i >> 6) & 15, t = (i >> 10) & 15, lg = i >> 14;
            const float ar = APOW[(((size_t)lg * 17 + t + 1) * 64 + p) * 2], ai = APOW[(((size_t)lg * 17 + t + 1) * 64 + p) * 2 + 1];
            const float cr = INP(20)[((size_t)lg * 16 + cp) * 64 + p], ci = INP(21)[((size_t)lg * 16 + cp) * 64 + p];
            bf16_t* by = BTY + ((size_t)lg * 256 + t * 16 + cp) * KY + 256; by[p] = f2bf(cr * ar - ci * ai); by[64 + p] = f2bf(-(cr * ai + ci * ar)); }
        for (int i = gt; i < DEPTH * 16 * 64 * 256; i += NGT) { const int c = i & 15, s = (i >> 4) & 15, p = (i >> 8) & 63, lg = i >> 14;
            const float ar = APOW[(((size_t)lg * 17 + 15 - s) * 64 + p) * 2], ai = APOW[(((size_t)lg * 17 + 15 - s) * 64 + p) * 2 + 1];
            const float br = BB[(((size_t)lg * 64 + p) * 16 + c) * 2], bi = BB[(((size_t)lg * 64 + p) * 16 + c) * 2 + 1];
            bf16_t* be = BTE + ((size_t)lg * 128 + p) * 256 + s * 16 + c; be[0] = f2bf(ar * br - ai * bi); be[(size_t)64 * 256] = f2bf(ar * bi + ai * br); }
        }
        __syncthreads();
        pg8::Gemm g{SC, WMOD, D, D, D, 0, (size_t)6144 * D * 2}; pg8::Order S; S.init(1, 24, DEPTH, G, bid, D / 64);
        EpiMod E{MOD, INP(12)};
        pg8::gemm_phase<EpiMod, true>(ldsl, g, S, E, wave);
    }
    PHASE_END

    PHASE_BEGIN
    norm_rows<false>(INP(0), INP(1), X, INP(9), MOD, MOD + 1024, XN, out, gw, NGW, lane, nullptr, 0);
    PHASE_END

#define MIX_TASK(task) do { if (task < 256) attn_prompt_unit(lds, Qb, Kb, Vb, MIX, sinks, task, tid); else if (task < 384) { __syncthreads(); attn_sample_wave((float*)(lds + wave * 4096), Qb, Kb, Vb, INP(4) + (size_t)l * NSB * 128 * 128, INP(5) + (size_t)l * NSB * 128 * 128, MIX, sinks, (task - 256) * 8 + wave, lane); } else if (task < 640) { __syncthreads(); ssm_sample_wave((float*)(lds + wave * 4096), ZUS, INP(6) + (size_t)l * NSB * 1024, INP(7) + (size_t)l * NSB * 1024, APOW + (size_t)l * 16 * 17 * 128, BB + (size_t)l * 16 * 64 * 32, INP(20) + (size_t)l * 16384, INP(21) + (size_t)l * 16384, INP(22) + l * 256, Zb, out + O_RS + (size_t)l * 131072, out + O_IS + (size_t)l * 131072, (task - 384) * 8 + wave, lane); } else if (task < 896) { const int tk = task - 640; _Pragma("unroll 1") for (int it = 0; it < 2; ++it) { const int tok = tk * 64 + (it * 8 + wave) * 4, t = tok & 4095; conv_group(VC, (size_t)tok, 30 - t, nullptr, INP(25) + (size_t)l * 31 * 256, INP(26) + l * 256, INP(27) + l * 256, INP(28) + l * 256, MIX, (size_t)tok, lane); } } else { const int b = (task - 896) * 8 + wave; conv_group(VC, (size_t)MP + b * 4, 0, INP(8) + ((size_t)l * NSB + b) * 30 * 256, INP(25) + (size_t)l * 31 * 256, INP(26) + l * 256, INP(27) + l * 256, INP(28) + l * 256, MIX, (size_t)MP + b * 4, lane); } } while (0)
#pragma unroll 1
    for (int l = 0; l < DEPTH; ++l) {
        PHASE_BEGIN
        {
            pg8::Gemm g{XN, WIN + (size_t)l * NIN * D, D, D, D, 0, 0}; pg8::Order S; S.init(M / 256, NIN / 256, 1, G, bid, D / 64);
            EpiIn E{Qb, Kb, Vb, ZUT, VC, ZUS, ROPE, out, l};
            pg8::gemm_phase<EpiIn, true>(ldsl, g, S, E, wave);
        }
        PHASE_END
        PHASE_BEGIN
        {
            const int NE = 64;
            if (bid < NE) {
                pg8::Gemm g{ZUT, BTE + (size_t)l * 16 * 128 * 256, 256, KY, 256, (size_t)NCHUNK * KY * 2, (size_t)128 * 256 * 2}; pg8::Order S; S.init(4, 1, 16, NE, bid, 4);
                EpiE E{ZUT, APOW + (size_t)l * 16 * 17 * 128, out + O_RP + (size_t)l * 4096, out + O_IP + (size_t)l * 4096};
                pg8::gemm_phase<EpiE, false>(ldsl, g, S, E, wave);
            }
            {
                const float* sinks = INP(14) + l * 8;
                for (int i = bid; i < 256; i += G) { const int task = i; MIX_TASK(task); }
                if (bid >= NE) for (int i = bid - NE; i < 256; i += G - NE) { const int task = 384 + i; MIX_TASK(task); }
                __syncthreads();
            }
        }
        PHASE_END
        PHASE_BEGIN
        {
            if (bid < 64) {
                pg8::Gemm g{ZUT, BTY + (size_t)l * 16 * 256 * KY, KY, KY, KY, (size_t)NCHUNK * KY * 2, (size_t)256 * KY * 2}; pg8::Order S; S.init(4, 1, 16, 64, bid, KY / 64);
                EpiY E{Zb};
                pg8::gemm_phase<EpiY, true>(ldsl, g, S, E, wave);
            } else {
                const float* sinks = INP(14) + l * 8;
                for (int i = bid - 64; i < 128; i += G - 64) { const int task = 256 + i; MIX_TASK(task); }
                __syncthreads();
            }
        }
        PHASE_END
        PHASE_BEGIN
        {
            pg8::Gemm g{Zb, WGLU + (size_t)l * 65536, 256, 256, 256, 0, 0}; pg8::Order S; S.init(M / 256, 1, 1, G, bid, 4);
            EpiGlu E{Zb, MIX, INP(24) + l * 256};
            pg8::gemm_phase<EpiGlu, true>(ldsl, g, S, E, wave);
            if (bid >= M / 256) {
#pragma unroll 1
                for (int i = bid - M / 256; i < 272; i += G - M / 256) {
                    if (i < 256) {
#pragma unroll 1
                        for (int it = 0; it < 2; ++it) { const int tok = i * 64 + (it * 8 + wave) * 4, t = tok & 4095;
                            conv_group(VC, (size_t)tok, 30 - t, nullptr, INP(25) + (size_t)l * 31 * 256, INP(26) + l * 256, INP(27) + l * 256, INP(28) + l * 256, MIX, (size_t)tok, lane); }
                    } else { const int b = (i - 256) * 8 + wave;
                        conv_group(VC, (size_t)MP + b * 4, 0, INP(8) + ((size_t)l * NSB + b) * 30 * 256, INP(25) + (size_t)l * 31 * 256, INP(26) + l * 256, INP(27) + l * 256, INP(28) + l * 256, MIX, (size_t)MP + b * 4, lane); }
                }
            }
        }
        PHASE_END
        PHASE_BEGIN
        {
            pg8::Gemm g{MIX, WOUT + (size_t)l * D * D, D, D, D, 0, 0}; pg8::Order S; S.init_split(MP / 256, MS / 256, D / 256, G, bid, D / 64);
            EpiRes E{l == 0 ? INP(0) : nullptr, INP(1), X, (MOD + (size_t)l * NMODROWS * 6144) + 2048, (float*)(ws + WS_PART)};
            pg8::gemm_phase<EpiRes, true>(ldsl, g, S, E, wave);
        }
        PHASE_END
        PHASE_BEGIN
        norm_rows<false>(nullptr, nullptr, X, INP(10) + l * D, (MOD + (size_t)l * NMODROWS * 6144) + 3072, (MOD + (size_t)l * NMODROWS * 6144) + 4096, XN, nullptr, gw, NGW, lane, (const float*)(ws + WS_PART), D / 256);
        PHASE_END
        PHASE_BEGIN
        {
            pg8::Gemm g{XN, WGU + (size_t)l * NGU * D, D, D, D, 0, 0}; pg8::Order S; S.init(M / 256, NGU / 256, 1, G, bid, D / 64);
            EpiGU E{Hb};
            pg8::gemm_phase<EpiGU, true>(ldsl, g, S, E, wave);
        }
        PHASE_END
        PHASE_BEGIN
        {
            pg8::Gemm g{Hb, WDN + (size_t)l * D * DFF, DFF, DFF, DFF, 0, 0}; pg8::Order S; S.init_split(MP / 256, MS / 256, D / 256, G, bid, DFF / 64);
            EpiRes E{nullptr, nullptr, X, (MOD + (size_t)l * NMODROWS * 6144) + 5120, (float*)(ws + WS_PART)};
            pg8::gemm_phase<EpiRes, true>(ldsl, g, S, E, wave);
        }
        PHASE_END
        PHASE_BEGIN
        if (l + 1 < DEPTH) norm_rows<false>(nullptr, nullptr, X, INP(9) + (l + 1) * D, (MOD + (size_t)l * NMODROWS * 6144) + (size_t)NMODROWS * 6144, (MOD + (size_t)l * NMODROWS * 6144) + (size_t)NMODROWS * 6144 + 1024, XN, nullptr, gw, NGW, lane, (const float*)(ws + WS_PART), DFF / 256);
        else norm_rows<true>(nullptr, nullptr, X, INP(33), nullptr, nullptr, nullptr, out, gw, NGW, lane, (const float*)(ws + WS_PART), DFF / 256);
        PHASE_END
    }
}
constexpr int N_PHASES = 3 + 9 * DEPTH;
#ifndef PH_LIMIT
#define PH_LIMIT N_PHASES
#endif

extern "C" void kernel_launch(void* const* d_in, const int* in_sizes, int n_in, void* d_out, int out_size, void* d_ws, size_t ws_size, hipStream_t stream) {
    static int grid = 0;
    if (grid == 0) {
        if (n_in != 34 || (size_t)out_size != O_END || ws_size < WS_END) { fprintf(stderr, "kernel_launch: unexpected sizes n_in %d out %d ws %zu\n", n_in, out_size, ws_size); grid = -1; return; }
        int dev = 0, cus = 0, per_cu = 0;
        hipGetDevice(&dev); hipDeviceGetAttribute(&cus, hipDeviceAttributeMultiprocessorCount, dev);
        hipFuncSetAttribute((const void*)hybrid_fwd, hipFuncAttributeMaxDynamicSharedMemorySize, LDS_BYTES);
        hipOccupancyMaxActiveBlocksPerMultiprocessor(&per_cu, (const void*)hybrid_fwd, 512, LDS_BYTES);
        if (per_cu < 1) { fprintf(stderr, "kernel_launch: occupancy query says %d blocks per CU\n", per_cu); per_cu = 1; }
        grid = cus * per_cu; if (grid < 128) { fprintf(stderr, "kernel_launch: grid %d too small\n", grid); grid = -1; return; }
        fprintf(stderr, "kernel_launch: grid %d (cus %d x %d)\n", grid, cus, per_cu);
    }
    if (grid < 0) return;
    if (hipMemsetAsync(d_ws, 0, XCD_BAR_WORDS * 4, stream) != hipSuccess) { fprintf(stderr, "kernel_launch: memset failed\n"); return; }
    Params p{};
    for (int i = 0; i < 34; ++i) p.in[i] = (const float*)d_in[i];
    p.out = (float*)d_out; p.ws = (unsigned char*)d_ws;
#if MK_LAUNCH_PER_PHASE
    for (int ph = 0; ph < PH_LIMIT; ++ph) { p.ph_lo = ph; p.ph_hi = ph + 1; hipLaunchKernelGGL(hybrid_fwd, dim3(grid), dim3(512), LDS_BYTES, stream, p); }
#else
    p.ph_lo = 0; p.ph_hi = N_PHASES;
    void* args[] = {&p};
    hipError_t e = hipLaunchCooperativeKernel((const void*)hybrid_fwd, dim3(grid), dim3(512), args, LDS_BYTES, stream);
    if (e != hipSuccess) fprintf(stderr, "cooperative launch failed: %s (grid %d)\n", hipGetErrorString(e), grid);
#endif
}
```
